# Optimizing an MI355X kernel written in HIP

```python
import jax, jax.numpy as jnp
from jax import lax
import numpy as np

D_MODEL = 1024
BATCH = 4
SEQ = 4096
DEPTH = 1

SB_HEADS = 8
SB_HEAD_DIM = 64
SB_WIDTH = SB_HEADS * SB_HEAD_DIM
Q_BLOCK = 128
CONV_GROUPS = 8
CONV_GROUP_DIM = 64
CONV_WIDTH = CONV_GROUPS * CONV_GROUP_DIM
CONV_KSIZE = 3
N_BRANCHES = 2
N_GROUPS = 4
EXPERTS_PER_GROUP = 8
N_EXPERTS = N_GROUPS * EXPERTS_PER_GROUP
TOP_K_IN_GROUP = 2
D_EXPERT = 256
NORM_EPS = 1e-6
IN_SIZES = (SB_WIDTH, SB_WIDTH, SB_WIDTH, CONV_WIDTH, CONV_WIDTH, CONV_WIDTH, D_MODEL, D_MODEL)
IN_PROJ_WIDTH = sum(IN_SIZES)
IN_SPLITS = tuple(int(s) for s in np.cumsum(IN_SIZES)[:-1])

kernel_name = "hybrid_stickbreak_shortconv_hmoe"


def rms_norm(x, g):
    xf = x.astype(jnp.float32)
    y = xf * lax.rsqrt(jnp.mean(xf * xf, axis=-1, keepdims=True) + NORM_EPS)
    return (y * g.astype(jnp.float32)).astype(x.dtype)


def stick_breaking_attention(q, k, v):
    B, H, S, dh = q.shape
    n_blocks = S // Q_BLOCK
    scale = SB_HEAD_DIM ** -0.5
    kf = k.astype(jnp.float32)
    vf = v.astype(jnp.float32)
    key_pos = jnp.arange(S)

    def one_block(i):
        start = i * Q_BLOCK
        qb = lax.dynamic_slice_in_dim(q, start, Q_BLOCK, axis=2).astype(jnp.float32)
        z = jnp.einsum('bhqd,bhkd->bhqk', qb, kf) * scale
        q_pos = start + jnp.arange(Q_BLOCK)
        mask = key_pos[None, :] < q_pos[:, None]
        neg_log_1m_beta = jnp.where(mask, jax.nn.softplus(z), 0.0)
        tail = lax.cumsum(neg_log_1m_beta, axis=3, reverse=True) - neg_log_1m_beta
        a = jnp.where(mask, jnp.exp(jax.nn.log_sigmoid(z) - tail), 0.0)
        return jnp.einsum('bhqk,bhkd->bhqd', a, vf)

    out = lax.map(one_block, jnp.arange(n_blocks))
    out = jnp.transpose(out, (1, 0, 3, 2, 4)).reshape(B, S, H * dh)
    return out.astype(q.dtype)


def short_conv_mixer(b_gate, c_gate, u, conv_w):
    S = u.shape[1]
    cu = c_gate * u
    cu_pad = jnp.pad(cu, ((0, 0), (CONV_KSIZE - 1, 0), (0, 0)))
    y = conv_w[0] * cu_pad[:, 0:S]
    for j in range(1, CONV_KSIZE):
        y = y + conv_w[j] * cu_pad[:, j:j + S]
    return b_gate * y


def hierarchical_moe(h, w_rg, b_rg, w_re, b_re, w_gate, w_up, w_down):
    N = h.shape[0]
    hf = h.astype(jnp.float32)
    g_logits = hf @ w_rg.astype(jnp.float32) + b_rg.astype(jnp.float32)
    g_prob = jax.nn.softmax(g_logits, axis=-1)
    _, g_idx = lax.top_k(g_logits, 1)
    g_w = jnp.take_along_axis(g_prob, g_idx, axis=-1)
    e_logits = (hf @ w_re.astype(jnp.float32) + b_re.astype(jnp.float32)).reshape(N, N_GROUPS, EXPERTS_PER_GROUP)
    e_in_group = jnp.take_along_axis(e_logits, g_idx[:, :, None], axis=1)[:, 0]
    top_v, top_i = lax.top_k(e_in_group, TOP_K_IN_GROUP)
    top_w = jax.nn.softmax(top_v, axis=-1)
    within = jnp.sum(jax.nn.one_hot(top_i, EXPERTS_PER_GROUP, dtype=jnp.float32) * top_w[..., None], axis=1)
    combine = (jax.nn.one_hot(g_idx[:, 0], N_GROUPS, dtype=jnp.float32)[:, :, None]
               * within[:, None, :] * g_w[:, :, None]).astype(h.dtype)
    y = jnp.zeros_like(h)
    for g in range(N_GROUPS):
        sl = slice(g * EXPERTS_PER_GROUP, (g + 1) * EXPERTS_PER_GROUP)
        act = jax.nn.silu(jnp.einsum('nd,edf->nef', h, w_gate[sl])) * jnp.einsum('nd,edf->nef', h, w_up[sl])
        act = act * combine[:, g, :, None]
        y = y + jnp.einsum('nef,efd->nd', act, w_down[sl])
    return y


def setup_inputs(seed: int = 0) -> dict:
    key = jax.random.key(seed)
    ks = jax.random.split(key, 20)
    f32 = jnp.float32
    nrm = lambda k, shape, fan_in: jax.random.normal(k, shape, f32) * (fan_in ** -0.5)
    gain = lambda k, shape: 1.0 + 0.05 * jax.random.normal(k, shape, f32)
    return {
        "x": jax.random.normal(ks[0], (BATCH, SEQ, D_MODEL), f32),
        "norm_mix_g": gain(ks[1], (DEPTH, D_MODEL)),
        "w_in": nrm(ks[2], (DEPTH, D_MODEL, IN_PROJ_WIDTH), D_MODEL),
        "q_norm_g": gain(ks[3], (DEPTH, SB_HEAD_DIM)),
        "k_norm_g": gain(ks[4], (DEPTH, SB_HEAD_DIM)),
        "conv_w": nrm(ks[5], (DEPTH, CONV_KSIZE, CONV_WIDTH), CONV_KSIZE),
        "w_sb_branch": nrm(ks[6], (DEPTH, SB_WIDTH, D_MODEL), SB_WIDTH),
        "w_conv_branch": nrm(ks[7], (DEPTH, CONV_WIDTH, D_MODEL), CONV_WIDTH),
        "w_out": nrm(ks[8], (DEPTH, D_MODEL, D_MODEL), D_MODEL),
        "norm_ffn_g": gain(ks[9], (DEPTH, D_MODEL)),
        "w_router_group": nrm(ks[10], (DEPTH, D_MODEL, N_GROUPS), D_MODEL),
        "b_router_group": 0.01 * jax.random.normal(ks[11], (DEPTH, N_GROUPS), f32),
        "w_router_expert": nrm(ks[12], (DEPTH, D_MODEL, N_EXPERTS), D_MODEL),
        "b_router_expert": 0.01 * jax.random.normal(ks[13], (DEPTH, N_EXPERTS), f32),
        "w_gate_e": nrm(ks[14], (DEPTH, N_EXPERTS, D_MODEL, D_EXPERT), D_MODEL),
        "w_up_e": nrm(ks[15], (DEPTH, N_EXPERTS, D_MODEL, D_EXPERT), D_MODEL),
        "w_down_e": nrm(ks[16], (DEPTH, N_EXPERTS, D_EXPERT, D_MODEL), D_EXPERT),
    }


def reference(x, norm_mix_g, w_in, q_norm_g, k_norm_g, conv_w, w_sb_branch, w_conv_branch,
              w_out, norm_ffn_g, w_router_group, b_router_group, w_router_expert,
              b_router_expert, w_gate_e, w_up_e, w_down_e):
    B, S, D = x.shape
    for l in range(DEPTH):
        h = rms_norm(x, norm_mix_g[l])
        proj = h @ w_in[l]
        q, k, v, c_b, c_c, c_u, g_a, g_b = jnp.split(proj, IN_SPLITS, axis=-1)
        q = rms_norm(q.reshape(B, S, SB_HEADS, SB_HEAD_DIM), q_norm_g[l]).transpose(0, 2, 1, 3)
        k = rms_norm(k.reshape(B, S, SB_HEADS, SB_HEAD_DIM), k_norm_g[l]).transpose(0, 2, 1, 3)
        v = v.reshape(B, S, SB_HEADS, SB_HEAD_DIM).transpose(0, 2, 1, 3)
        branch_a = stick_breaking_attention(q, k, v) @ w_sb_branch[l]
        branch_b = short_conv_mixer(c_b, c_c, c_u, conv_w[l]) @ w_conv_branch[l]
        merged = jax.nn.sigmoid(g_a) * branch_a + jax.nn.sigmoid(g_b) * branch_b
        x = x + merged @ w_out[l]
        h2 = rms_norm(x, norm_ffn_g[l]).reshape(B * S, D)
        y = hierarchical_moe(h2, w_router_group[l], b_router_group[l], w_router_expert[l],
                             b_router_expert[l], w_gate_e[l], w_up_e[l], w_down_e[l])
        x = x + y.reshape(B, S, D)
    return x
```

```cpp
#include <hip/hip_runtime.h>
#include <cstdio>
#include <cstdint>

#define LAS __attribute__((address_space(3)))
#define GAS __attribute__((address_space(1)))
typedef _Float16 h16;
typedef h16 h16x8 __attribute__((ext_vector_type(8)));
typedef h16 h16x4 __attribute__((ext_vector_type(4)));
typedef h16 h16x2 __attribute__((ext_vector_type(2)));
typedef float f32x2 __attribute__((ext_vector_type(2)));
typedef float f32x4 __attribute__((ext_vector_type(4)));
typedef float f32x16 __attribute__((ext_vector_type(16)));
typedef unsigned u32x2 __attribute__((ext_vector_type(2)));
typedef unsigned u32x4 __attribute__((ext_vector_type(4)));
typedef int i32x4 __attribute__((ext_vector_type(4)));

#ifndef MK_N_LAUNCHES
#define MK_N_LAUNCHES 1
#endif
constexpr int N_PHASES = 9;

constexpr int NTOK = 16384, SEQ = 4096, DM = 1024, NH = 8, HD = 64, AW = 512, NPROJ = 5120, NEXP = 32, DEXP = 256;
constexpr float EPS = 1e-6f;
constexpr int LCAP = 16384;
constexpr size_t MiB = 1u << 20;
constexpr size_t WS_CTL = 0, CTL_BYTES = 256 * 1024;
constexpr size_t WS_RW = 512 * 1024;
constexpr size_t WS_WIN = 1 * MiB, WS_WSB = 11 * MiB, WS_WCV = 12 * MiB, WS_WOUT = 13 * MiB, WS_W1 = 15 * MiB, WS_W2 = 47 * MiB;
constexpr size_t WS_H = 63 * MiB;
constexpr size_t WS_Q = 95 * MiB, WS_K = 111 * MiB, WS_VT = 127 * MiB, WS_CB = 143 * MiB, WS_CC = 159 * MiB, WS_CU = 175 * MiB, WS_GA = 191 * MiB, WS_GB = 223 * MiB;
constexpr size_t WS_ACT = WS_Q;
constexpr size_t WS_Y = WS_VT;
constexpr size_t WS_TOK = WS_GB, WS_WL = WS_GB + 2 * MiB, WS_ROUTE = WS_GB + 4 * MiB;
constexpr size_t WS_END = 256 * MiB;
constexpr int CW_CNT = 64;
constexpr int CW_BAR = 4096;

constexpr int RING_BYTES = 131072;
constexpr int SCR_BYTES = 147456;
constexpr int MISC_OFF = SCR_BYTES;
constexpr int LDS_BYTES = SCR_BYTES + 1024;

#define LDS_WAIT() asm volatile("s_waitcnt lgkmcnt(0)" ::: "memory")
#define VM_WAIT() asm volatile("s_waitcnt vmcnt(0)" ::: "memory")

__device__ __forceinline__ unsigned pkh(float lo, float hi) { f32x2 v = {lo, hi}; h16x2 b = __builtin_convertvector(v, h16x2); return __builtin_bit_cast(unsigned, b); }
__device__ __forceinline__ float wave_sum(float v) {
#pragma unroll
    for (int o = 1; o < 64; o <<= 1) v += __shfl_xor(v, o);
    return v;
}
__device__ __forceinline__ float sigmoidf_(float x) { return __builtin_amdgcn_rcpf(1.0f + __expf(-x)); }

namespace pg8 {
constexpr int BM = 256, BK = 64, HALF = 128, HTB = HALF * BK * 2, NXCD = 8, WGM = 8;
__device__ __forceinline__ int lds_byte(int r, int c) { const int st = (r >> 4) * 2 + (c >> 5), rr = r & 15, cc = c & 31, ob = rr * 64 + cc * 2; return st * 1024 + (ob ^ (((ob >> 9) & 1) << 5)); }
__device__ __forceinline__ void stage_rc(int b, int& R, int& C) { const int st = b / 1024, sb = b % 1024, swz = sb ^ (((sb >> 9) & 1) << 5); R = (st >> 1) * 16 + swz / 64; C = (st & 1) * 32 + (swz % 64) / 2; }
__device__ __forceinline__ int perm32(int rho) { const int n = rho >> 4, i = rho & 15; return 8 * (i >> 2) + 4 * n + (i & 3); }

struct Unit { const char* a; const char* b; const int* lst; const float* wl; int pm, pn, e, nrows; };

__device__ __forceinline__ void tile_of(int L, int nM, int nN, int& pm, int& pn) {
    const int nwg = nM * nN; int wgid = L; { const int q = nwg / NXCD, r = nwg % NXCD, xcd = wgid % NXCD, off = wgid / NXCD; wgid = (xcd < r ? xcd * (q + 1) : r * (q + 1) + (xcd - r) * q) + off; }
    const int nig = WGM * nN, gid = wgid / nig, fm = gid * WGM, gsz = (nM - fm) < WGM ? (nM - fm) : WGM;
    pm = fm + ((wgid % nig) % gsz); pn = (wgid % nig) / gsz;
}

template <class Epi, class Sched, bool GATHER>
__device__ __forceinline__ void gemm_phase(LAS unsigned char* lds, const int K, const Sched& S, const Epi& E) {
    const int tid = threadIdx.x, wid = __builtin_amdgcn_readfirstlane(tid >> 6), lane = tid & 63, wr = wid >> 2, wc = wid & 3, fr = lane & 15, fq = lane >> 4;
    const int nt = K / BK;
    unsigned voffA[2], voffB[2]; int RA[2], CA[2];
#pragma unroll
    for (int i = 0; i < 2; ++i) { int R, C; stage_rc(tid * 16 + i * 8192, R, C); const int Rb = Epi::PERM ? ((R & ~31) + perm32(R & 31)) : R;
        RA[i] = R; CA[i] = C; voffA[i] = (unsigned)(R * K + C) * 2u; voffB[i] = (unsigned)(Rb * K + C) * 2u; }
    const size_t kstep = (size_t)(BK * 2);
    const size_t hstep = (size_t)HALF * K * 2;
    const unsigned ldsw = (unsigned)wid * 1024u;
    const int aoff = lds_byte(wr * 64 + fr, fq * 8), boff = lds_byte(wc * 32 + fr, fq * 8);
#define PG8_SA(b, h) (((b) * 2 + (h)) * HTB)
#define PG8_SB(b, h) ((4 + (b) * 2 + (h)) * HTB)
#define PG8_GLDS(bufoff, gptr, i) __builtin_amdgcn_global_load_lds((const unsigned*)(gptr), (LAS unsigned*)(lds + (bufoff) + ldsw + (i) * 8192), 16, 0, 0)
#define PG8_STAGE_B(bufoff, gbase, h) do { PG8_GLDS(bufoff, (const char*)(gbase) + (h) * hstep + voffB[0], 0); PG8_GLDS(bufoff, (const char*)(gbase) + (h) * hstep + voffB[1], 1); } while (0)
#define PG8_STAGE_A(bufoff, gbase, h, v0, v1) do { if constexpr (GATHER) { PG8_GLDS(bufoff, (const char*)(gbase) + (v0), 0); PG8_GLDS(bufoff, (const char*)(gbase) + (v1), 1); } \
        else { PG8_GLDS(bufoff, (const char*)(gbase) + (h) * hstep + voffA[0], 0); PG8_GLDS(bufoff, (const char*)(gbase) + (h) * hstep + voffA[1], 1); } } while (0)
#define PG8_LDA(dst, b, h) do { _Pragma("unroll") for (int m = 0; m < 4; ++m) _Pragma("unroll") for (int k = 0; k < 2; ++k) dst[m][k] = *(const LAS h16x8*)(lds + PG8_SA(b, h) + aoff + m * 2048 + k * 1024); } while (0)
#define PG8_LDB(dst, b, h) do { _Pragma("unroll") for (int n = 0; n < 2; ++n) _Pragma("unroll") for (int k = 0; k < 2; ++k) dst[n][k] = *(const LAS h16x8*)(lds + PG8_SB(b, h) + boff + n * 2048 + k * 1024); } while (0)
#define PG8_MMA(ai, bj, At, Bt) do { __builtin_amdgcn_s_setprio(1); _Pragma("unroll") for (int m = 0; m < 4; ++m) _Pragma("unroll") for (int n = 0; n < 2; ++n) _Pragma("unroll") for (int k = 0; k < 2; ++k) \
        acc[ai][bj][m][n] = __builtin_amdgcn_mfma_f32_16x16x32_f16(Bt[n][k], At[m][k], acc[ai][bj][m][n], 0, 0, 0); __builtin_amdgcn_s_setprio(0); } while (0)
#define PG8_WAIT_V(n) asm volatile("s_waitcnt vmcnt(" #n ")" ::: "memory")
#define PG8_WAIT_L(n) asm volatile("s_waitcnt lgkmcnt(" #n ")" ::: "memory")
#define PG8_BAR __builtin_amdgcn_s_barrier()
#define PG8_SCHED __builtin_amdgcn_sched_barrier(0)
    Unit cur, nxt; int ui = 0;
    if (!S.next(0, cur)) return;
    f32x4 acc[2][2][4][2];
#pragma unroll
    for (int a = 0; a < 2; ++a)
#pragma unroll
        for (int b = 0; b < 2; ++b)
#pragma unroll
            for (int m = 0; m < 4; ++m)
#pragma unroll
                for (int n = 0; n < 2; ++n) acc[a][b][m][n] = (f32x4){0.f, 0.f, 0.f, 0.f};
    h16x8 At[4][2], B0[2][2], B1[2][2];
    const char* cA = cur.a; const char* cB = cur.b;
    unsigned gc00 = 0, gc01 = 0, gc10 = 0, gc11 = 0, gn00 = 0, gn01 = 0, gn10 = 0, gn11 = 0;
#define PG8_GOFF(u, h, i) ((unsigned)(S.tok(u, (h) * HALF + RA[i]) * K + CA[i]) * 2u)
    if constexpr (GATHER) { gc00 = PG8_GOFF(cur, 0, 0); gc01 = PG8_GOFF(cur, 0, 1); gc10 = PG8_GOFF(cur, 1, 0); gc11 = PG8_GOFF(cur, 1, 1); }
    PG8_STAGE_B(PG8_SB(0, 0), cB, 0); PG8_STAGE_B(PG8_SB(0, 1), cB, 1); PG8_STAGE_A(PG8_SA(0, 0), cA, 0, gc00, gc01); PG8_STAGE_A(PG8_SA(0, 1), cA, 1, gc10, gc11);
    if (wr == 1) PG8_BAR;
    PG8_WAIT_V(2); PG8_BAR;
    PG8_STAGE_B(PG8_SB(1, 0), cB + kstep, 0); PG8_STAGE_A(PG8_SA(1, 0), cA + kstep, 0, gc00, gc01); PG8_STAGE_B(PG8_SB(1, 1), cB + kstep, 1);
    PG8_WAIT_V(6); PG8_BAR;
    for (;;) {
        const bool has_next = S.next(ui + 1, nxt);
        const char* nA = has_next ? nxt.a : cA; const char* nB = has_next ? nxt.b : cB;
        if constexpr (GATHER) { if (has_next) { gn00 = PG8_GOFF(nxt, 0, 0); gn01 = PG8_GOFF(nxt, 0, 1); gn10 = PG8_GOFF(nxt, 1, 0); gn11 = PG8_GOFF(nxt, 1, 1); } else { gn00 = gc00; gn01 = gc01; gn10 = gc10; gn11 = gc11; } }
#pragma unroll 1
        for (int t = 0; t < nt; t += 2) {
            const bool last = (t == nt - 2);
            const char* a1 = cA + (size_t)(t + 1) * kstep;
            const char* a2 = last ? nA : cA + (size_t)(t + 2) * kstep; const char* b2 = last ? nB : cB + (size_t)(t + 2) * kstep;
            const char* a3 = a2 + kstep; const char* b3 = b2 + kstep;
            unsigned s00 = gc00, s01 = gc01, s10 = gc10, s11 = gc11;
            if constexpr (GATHER) { if (last) { s00 = gn00; s01 = gn01; s10 = gn10; s11 = gn11; } }
            PG8_LDB(B0, 0, 0); PG8_LDB(B1, 0, 1); PG8_SCHED; PG8_LDA(At, 0, 0); PG8_STAGE_A(PG8_SA(1, 1), a1, 1, gc10, gc11);
            PG8_WAIT_V(8); PG8_WAIT_L(0); PG8_BAR; PG8_MMA(0, 0, At, B0); PG8_MMA(0, 1, At, B1); PG8_BAR; PG8_SCHED;
            PG8_LDA(At, 0, 1); PG8_STAGE_B(PG8_SB(0, 0), b2, 0); PG8_STAGE_B(PG8_SB(0, 1), b2, 1); PG8_STAGE_A(PG8_SA(0, 0), a2, 0, s00, s01);
            PG8_WAIT_V(8); PG8_WAIT_L(0); PG8_BAR; PG8_MMA(1, 0, At, B0); PG8_MMA(1, 1, At, B1); PG8_BAR; PG8_SCHED;
            PG8_LDB(B0, 1, 0); PG8_LDB(B1, 1, 1); PG8_SCHED; PG8_LDA(At, 1, 0); PG8_STAGE_A(PG8_SA(0, 1), a2, 1, s10, s11);
            PG8_WAIT_V(8); PG8_WAIT_L(0); PG8_BAR; PG8_MMA(0, 0, At, B0); PG8_MMA(0, 1, At, B1); PG8_BAR; PG8_SCHED;
            PG8_LDA(At, 1, 1); PG8_STAGE_B(PG8_SB(1, 0), b3, 0); PG8_STAGE_B(PG8_SB(1, 1), b3, 1); PG8_STAGE_A(PG8_SA(1, 0), a3, 0, s00, s01);
            PG8_WAIT_V(8); PG8_WAIT_L(0); PG8_BAR; PG8_MMA(1, 0, At, B0); PG8_MMA(1, 1, At, B1); PG8_BAR; PG8_SCHED;
        }
        if (wr == 0) PG8_BAR;
        E(acc, cur, wr, wc, fr, fq);
        if (!has_next) break;
#pragma unroll
        for (int a = 0; a < 2; ++a)
#pragma unroll
            for (int b = 0; b < 2; ++b)
#pragma unroll
                for (int m = 0; m < 4; ++m)
#pragma unroll
                    for (int n = 0; n < 2; ++n) acc[a][b][m][n] = (f32x4){0.f, 0.f, 0.f, 0.f};
        cur = nxt; cA = nA; cB = nB; ++ui;
        if constexpr (GATHER) { gc00 = gn00; gc01 = gn01; gc10 = gn10; gc11 = gn11; }
        if (wr == 1) PG8_BAR;
    }
    PG8_WAIT_V(0);
    PG8_BAR;
#undef PG8_SA
#undef PG8_SB
#undef PG8_GLDS
#undef PG8_STAGE_A
#undef PG8_STAGE_B
#undef PG8_LDA
#undef PG8_LDB
#undef PG8_MMA
#undef PG8_WAIT_V
#undef PG8_WAIT_L
#undef PG8_BAR
#undef PG8_SCHED
#undef PG8_GOFF
}
}
using pg8::Unit;

#define XB_TMO      128
#define XB_XCNT(j)  (256  + 64 * (j))
#define XB_XSUB(j)  (1280 + 64 * (j))
#define XB_XGEN(j)  (2304 + 64 * (j))
#define XB_TOP      3328
#define XB_TOPGEN   3392
#define XCD_BAR_WORDS 3456
#define XB_SPIN_CAP (1u << 20)
__device__ __forceinline__ unsigned xb_ld(unsigned* p)              { return __hip_atomic_load(p, __ATOMIC_RELAXED, __HIP_MEMORY_SCOPE_AGENT); }
__device__ __forceinline__ unsigned xb_add(unsigned* p, unsigned v) { return __hip_atomic_fetch_add(p, v, __ATOMIC_RELAXED, __HIP_MEMORY_SCOPE_AGENT); }
__device__ __forceinline__ unsigned xb_xcc_id() { return (unsigned)__builtin_amdgcn_s_getreg((3 << 11) | 20) & 0xFu; }
#define XB_SPIN(cond, bar) do { unsigned _sp = 0; while (cond) { __builtin_amdgcn_s_sleep(1); \
    if ((++_sp & 255u) == 0u) { if (xb_ld(&(bar)[XB_TMO])) break; if (_sp > XB_SPIN_CAP) { atomicAdd(&(bar)[XB_TMO], 1u); break; } } } } while (0)
struct XcdBarrier { unsigned* bar; unsigned x; volatile LAS unsigned* st; };
__device__ __forceinline__ XcdBarrier xcd_barrier_post(unsigned* bar, volatile LAS unsigned* st) {
    XcdBarrier b; b.bar = bar; b.x = xb_xcc_id(); b.st = st;
    if (threadIdx.x == 0) (void)xb_add(&bar[XB_XCNT(b.x)], 1u);
    return b;
}
__device__ __forceinline__ void xcd_barrier_complete(unsigned* bar, unsigned x, unsigned& nloc, unsigned& nx) {
    const unsigned G = gridDim.x * gridDim.y * gridDim.z;
    unsigned sum, cnt, mine, sp = 0u;
    for (;;) {
        sum = 0u; cnt = 0u; mine = 0u;
#pragma unroll
        for (unsigned j = 0; j < 16; ++j) { const unsigned c = xb_ld(&bar[XB_XCNT(j)]); sum += c; cnt += (c > 0u) ? 1u : 0u; mine = (j == x) ? c : mine; }
        if (sum == G) break;
        __builtin_amdgcn_s_sleep(1);
        if ((++sp & 255u) == 0u) { if (xb_ld(&bar[XB_TMO])) break; if (sp > XB_SPIN_CAP) { atomicAdd(&bar[XB_TMO], 1u); break; } }
    }
    nloc = mine > 0u ? mine : 1u; nx = cnt > 0u ? cnt : 1u;
}
__device__ __forceinline__ void xcd_barrier(const XcdBarrier& b) {
    asm volatile("s_waitcnt vmcnt(0)" ::: "memory");
    __syncthreads();
    if (threadIdx.x == 0) {
        unsigned* bar = b.bar;
        __builtin_amdgcn_s_waitcnt(0);
        unsigned nloc = b.st[0], nx = b.st[1];
        if (nloc == 0u) { xcd_barrier_complete(bar, b.x, nloc, nx); b.st[0] = nloc; b.st[1] = nx; }
        const unsigned old = xb_add(&bar[XB_XSUB(b.x)], 1u);
        const unsigned gen = old / nloc;
        if (old + 1u == (gen + 1u) * nloc) {
            __builtin_amdgcn_fence(__ATOMIC_RELEASE, "agent");
            asm volatile("s_waitcnt vmcnt(0)" ::: "memory");
            const unsigned og = xb_add(&bar[XB_TOP], 1u);
            const unsigned tg = og / nx;
            if (og + 1u == (tg + 1u) * nx) xb_add(&bar[XB_TOPGEN], 1u);
            else XB_SPIN(xb_ld(&bar[XB_TOPGEN]) == tg, bar);
            __builtin_amdgcn_fence(__ATOMIC_ACQUIRE, "agent");
            xb_add(&bar[XB_XGEN(b.x)], 1u);
            asm volatile("s_waitcnt vmcnt(0)" ::: "memory");
        } else {
            XB_SPIN(xb_ld(&bar[XB_XGEN(b.x)]) == gen, bar);
            __builtin_amdgcn_fence(__ATOMIC_ACQUIRE, "agent");
            asm volatile("s_waitcnt vmcnt(0)" ::: "memory");
        }
    }
    __syncthreads();
}

struct Args { const float* in[17]; float* out; unsigned char* ws; int ph_lo, ph_hi; };
struct Frame {
    LAS unsigned char* lds; volatile LAS unsigned* MISC; unsigned* ctl;
    int tid, lane, wave, vcu, G;
    const float* in[17]; float* out; unsigned char* ws;
};

__device__ __forceinline__ void p0_transpose_item(const float* W, int ldw, h16* WT, int K, int k0, int n0, int drow0, LAS float* scr, int lane) {
#pragma unroll 8
    for (int i = 0; i < 32; ++i) { const int kk = 2 * i + (lane >> 5); scr[kk * 33 + (lane & 31)] = W[(size_t)(k0 + kk) * ldw + n0 + (lane & 31)]; }
    LDS_WAIT(); asm volatile("" ::: "memory");
    const int c = lane & 7;
#pragma unroll
    for (int j = 0; j < 4; ++j) { const int n = (lane >> 3) + 8 * j; const LAS float* s = scr + (8 * c) * 33 + n;
        u32x4 o; o.x = pkh(s[0 * 33], s[1 * 33]); o.y = pkh(s[2 * 33], s[3 * 33]); o.z = pkh(s[4 * 33], s[5 * 33]); o.w = pkh(s[6 * 33], s[7 * 33]);
        *(u32x4*)(WT + (size_t)(drow0 + n) * K + k0 + 8 * c) = o; }
    LDS_WAIT(); asm volatile("" ::: "memory");
}
__device__ __forceinline__ void p0_prologue(Frame& F) {
    LAS float* scr = (LAS float*)(F.lds + F.wave * 16384);
    const int gw = F.vcu * 8 + F.wave, NGW = F.G * 8, lane = F.lane;
    unsigned char* ws = F.ws;
    constexpr int I_IN = 16 * 160, I_SB = 8 * 32, I_CV = 8 * 32, I_OUT = 16 * 32, I_G = 32 * 16 * 8, I_U = I_G, I_D = 32 * 4 * 32;
    constexpr int NITEMS = I_IN + I_SB + I_CV + I_OUT + I_G + I_U + I_D;
    for (int it = gw; it < NITEMS; it += NGW) {
        int r = it;
        if (r < I_IN) { const int kb = r / 160, nb = r % 160, n0 = nb * 32; int drow = n0;
            if (n0 < 1536) { const int tile = n0 >> 8, within = n0 & 255, wc = within >> 6, bj = (within >> 5) & 1; drow = tile * 256 + 128 * bj + 32 * wc; }
            p0_transpose_item(F.in[2], NPROJ, (h16*)(ws + WS_WIN), DM, kb * 64, n0, drow, scr, lane); continue; } r -= I_IN;
        if (r < I_SB) { const int kb = r / 32, nb = r % 32; p0_transpose_item(F.in[6], DM, (h16*)(ws + WS_WSB), AW, kb * 64, nb * 32, nb * 32, scr, lane); continue; } r -= I_SB;
        if (r < I_CV) { const int kb = r / 32, nb = r % 32; p0_transpose_item(F.in[7], DM, (h16*)(ws + WS_WCV), AW, kb * 64, nb * 32, nb * 32, scr, lane); continue; } r -= I_CV;
        if (r < I_OUT) { const int kb = r / 32, nb = r % 32; p0_transpose_item(F.in[8], DM, (h16*)(ws + WS_WOUT), DM, kb * 64, nb * 32, nb * 32, scr, lane); continue; } r -= I_OUT;
        if (r < I_G + I_U) { const int up = r >= I_G; if (up) r -= I_G; const int e = r / 128, q = r % 128, kb = q / 8, nb = q % 8, n0 = nb * 32;
            const int drow = 256 * (n0 >> 7) + 128 * up + (n0 & 127);
            p0_transpose_item(F.in[up ? 15 : 14] + (size_t)e * DM * DEXP, DEXP, (h16*)(ws + WS_W1) + (size_t)e * 512 * DM, DM, kb * 64, n0, drow, scr, lane); continue; } r -= I_G + I_U;
        { const int e = r / 128, q = r % 128, kb = q / 32, nb = q % 32;
            p0_transpose_item(F.in[16] + (size_t)e * DEXP * DM, DM, (h16*)(ws + WS_W2) + (size_t)e * DM * DEXP, DEXP, kb * 64, nb * 32, nb * 32, scr, lane); }
    }
    { float* RW = (float*)(ws + WS_RW); const float* g2 = F.in[9]; const float* wg = F.in[10]; const float* we = F.in[12];
      for (int i = (F.vcu * 8 + F.wave) * 64 + lane; i < 36 * 1024; i += F.G * 512) { const int c = i >> 10, k = i & 1023; RW[i] = g2[k] * (c < 4 ? wg[k * 4 + c] : we[k * 32 + (c - 4)]); } }
    { const float* g1 = F.in[1]; h16* H = (h16*)(ws + WS_H);
      f32x4 gv[4];
#pragma unroll
      for (int j = 0; j < 4; ++j) gv[j] = ((const f32x4*)g1)[lane + 64 * j];
      for (int m = gw; m < NTOK; m += NGW) {
        const f32x4* xr = (const f32x4*)(F.in[0] + (size_t)m * DM) + lane;
        f32x4 v[4]; float s = 0.f;
#pragma unroll
        for (int j = 0; j < 4; ++j) { v[j] = xr[64 * j]; s += (v[j].x * v[j].x + v[j].y * v[j].y) + (v[j].z * v[j].z + v[j].w * v[j].w); }
        const float rstd = rsqrtf(wave_sum(s) * (1.f / DM) + EPS);
        u32x2* o8 = (u32x2*)(H + (size_t)m * DM) + lane;
#pragma unroll
        for (int j = 0; j < 4; ++j) { const f32x4 y = v[j] * rstd * gv[j]; u32x2 w; w.x = pkh(y.x, y.y); w.y = pkh(y.z, y.w); o8[64 * j] = w; }
      } }
}

struct StaticOrder {
    const char* A; const char* Bt; int nM, nN, G, c; size_t tstep;
    __device__ __forceinline__ bool next(int i, Unit& u) const {
        const int L = i * G + c; if (L >= nM * nN) return false;
        int pm, pn; pg8::tile_of(L, nM, nN, pm, pn); u.pm = pm; u.pn = pn; u.e = 0; u.nrows = 256; u.lst = nullptr; u.wl = nullptr;
        u.a = A + (size_t)pm * tstep; u.b = Bt + (size_t)pn * tstep; return true;
    }
    __device__ __forceinline__ int tok(const Unit&, int) const { return 0; }
};
struct BranchOrder {
    const char* Aa; const char* Ab; const char* Ba; const char* Bb; int G, c;
    __device__ __forceinline__ bool next(int i, Unit& u) const {
        const int L = (i >> 1) * G + c; if (L >= 64 * 4) return false;
        int pm, pn; pg8::tile_of(L, 64, 4, pm, pn); u.pm = pm; u.pn = pn; u.e = i & 1; u.nrows = 256; u.lst = nullptr; u.wl = nullptr;
        const size_t tstep = (size_t)256 * AW * 2;
        u.a = ((i & 1) ? Ab : Aa) + (size_t)pm * tstep; u.b = ((i & 1) ? Bb : Ba) + (size_t)pn * tstep; return true;
    }
    __device__ __forceinline__ int tok(const Unit&, int) const { return 0; }
};
template <int NN, bool G1> struct MoeOrder {
    const LAS int* cntl; const char* A; const char* Bt; const int* tok_list; const float* w_list; int G, c;
    __device__ __forceinline__ bool next(int i, Unit& u) const {
        const int L = i * G + c, mtg = L / NN, pn = L % NN;
        int acc = 0, e = -1, mtl = 0, ce = 0;
        for (int j = 0; j < NEXP; ++j) { const int cj = cntl[j], t = (cj + 255) >> 8; if (e < 0 && mtg < acc + t) { e = j; mtl = mtg - acc; ce = cj; } acc += t; }
        if (e < 0) return false;
        e = __builtin_amdgcn_readfirstlane(e); mtl = __builtin_amdgcn_readfirstlane(mtl); ce = __builtin_amdgcn_readfirstlane(ce);
        u.pm = mtg; u.pn = pn; u.e = e; const int nr = ce - mtl * 256; u.nrows = nr < 256 ? nr : 256;
        u.lst = tok_list + (size_t)e * LCAP + mtl * 256; u.wl = w_list + (size_t)e * LCAP + mtl * 256;
        if (G1) { u.a = A; u.b = Bt + ((size_t)e * 512 + pn * 256) * DM * 2; }
        else { u.a = A + (size_t)mtg * 256 * DEXP * 2; u.b = Bt + ((size_t)e * DM + pn * 256) * DEXP * 2; }
        return true;
    }
    __device__ __forceinline__ int tok(const Unit& u, int r) const { return r < u.nrows ? u.lst[r] : 0; }
};

__device__ __forceinline__ u32x4 pack8(const f32x4 a, const f32x4 b) { u32x4 w; w.x = pkh(a[0], a[1]); w.y = pkh(a[2], a[3]); w.z = pkh(b[0], b[1]); w.w = pkh(b[2], b[3]); return w; }
__device__ __forceinline__ void unpack8(const u32x4 w, f32x4& a, f32x4& b) {
    const h16x8 h = __builtin_bit_cast(h16x8, w);
    a = (f32x4){(float)h[0], (float)h[1], (float)h[2], (float)h[3]}; b = (f32x4){(float)h[4], (float)h[5], (float)h[6], (float)h[7]};
}
struct EpiProj {
    static constexpr bool PERM = true;
    unsigned char* ws; const float* qg; const float* kg;
    __device__ __forceinline__ void operator()(const f32x4 (&acc)[2][2][4][2], const Unit& u, int wr, int wc, int fr, int fq) const {
        const int row0 = u.pm * 256 + wr * 64 + fr, pn = u.pn;
        if (pn < 4) {
            const bool isq = pn < 2; const int head = 4 * (pn & 1) + wc; const float* gp = isq ? qg : kg; const float sc = isq ? 0.125f : 1.0f;
            h16* dst = (h16*)(ws + (isq ? WS_Q : WS_K));
            const f32x4 g00 = *(const f32x4*)(gp + 8 * fq), g01 = *(const f32x4*)(gp + 8 * fq + 4), g10 = *(const f32x4*)(gp + 32 + 8 * fq), g11 = *(const f32x4*)(gp + 32 + 8 * fq + 4);
#pragma unroll
            for (int ai = 0; ai < 2; ++ai)
#pragma unroll
                for (int m = 0; m < 4; ++m) {
                    const f32x4 a0 = acc[ai][0][m][0], a1 = acc[ai][0][m][1], b0 = acc[ai][1][m][0], b1 = acc[ai][1][m][1];
                    float ss = (a0[0] * a0[0] + a0[1] * a0[1]) + (a0[2] * a0[2] + a0[3] * a0[3]) + (a1[0] * a1[0] + a1[1] * a1[1]) + (a1[2] * a1[2] + a1[3] * a1[3])
                             + (b0[0] * b0[0] + b0[1] * b0[1]) + (b0[2] * b0[2] + b0[3] * b0[3]) + (b1[0] * b1[0] + b1[1] * b1[1]) + (b1[2] * b1[2] + b1[3] * b1[3]);
                    ss += __shfl_xor(ss, 16); ss += __shfl_xor(ss, 32);
                    const float r = rsqrtf(ss * (1.f / HD) + EPS) * sc;
                    h16* rowp = dst + (size_t)(row0 + ai * 128 + m * 16) * AW + head * HD + 8 * fq;
                    *(u32x4*)(rowp) = pack8(a0 * r * g00, a1 * r * g01);
                    *(u32x4*)(rowp + 32) = pack8(b0 * r * g10, b1 * r * g11);
                }
        } else if (pn < 6) {
            const int head = 4 * (pn & 1) + wc; h16* VT = (h16*)(ws + WS_VT);
            const int pf = fr ^ ((((fr >> 2) ^ (fr >> 3)) & 1) ? 12 : 0);
#pragma unroll
            for (int ai = 0; ai < 2; ++ai)
#pragma unroll
                for (int m = 0; m < 4; ++m) {
                    const int row = row0 + ai * 128 + m * 16, b = row >> 12, s = row & (SEQ - 1);
                    h16* colp = VT + ((size_t)(b * NH + head) * HD + 8 * fq) * SEQ + (s & ~15) + pf;
#pragma unroll
                    for (int bj = 0; bj < 2; ++bj)
#pragma unroll
                        for (int n = 0; n < 2; ++n)
#pragma unroll
                            for (int j = 0; j < 4; ++j) colp[(size_t)(32 * bj + 4 * n + j) * SEQ] = (h16)acc[ai][bj][m][n][j];
                }
        } else {
            const bool gate = pn >= 12; h16* dst; int ldc, col0;
            if (!gate) { const int w = (pn - 6) >> 1; dst = (h16*)(ws + WS_CB + (size_t)w * 16 * MiB); ldc = AW; col0 = ((pn - 6) & 1) * 256; }
            else { const int w = (pn - 12) >> 2; dst = (h16*)(ws + WS_GA + (size_t)w * 32 * MiB); ldc = DM; col0 = ((pn - 12) & 3) * 256; }
            col0 += wc * 32 + 8 * fq;
#pragma unroll
            for (int ai = 0; ai < 2; ++ai)
#pragma unroll
                for (int m = 0; m < 4; ++m) { h16* rowp = dst + (size_t)(row0 + ai * 128 + m * 16) * ldc + col0;
#pragma unroll
                    for (int bj = 0; bj < 2; ++bj) { f32x4 v0 = acc[ai][bj][m][0], v1 = acc[ai][bj][m][1];
                        if (gate) {
#pragma unroll
                            for (int j = 0; j < 4; ++j) { v0[j] = sigmoidf_(v0[j]); v1[j] = sigmoidf_(v1[j]); } }
                        *(u32x4*)(rowp + bj * 128) = pack8(v0, v1); } }
        }
    }
};
struct EpiBranch {
    static constexpr bool PERM = true;
    unsigned char* ws;
    __device__ __forceinline__ void operator()(const f32x4 (&acc)[2][2][4][2], const Unit& u, int wr, int wc, int fr, int fq) const {
        const int row0 = u.pm * 256 + wr * 64 + fr; const int col0 = u.pn * 256 + wc * 32 + 8 * fq; const bool second = u.e != 0;
        const h16* gt = (const h16*)(ws + (second ? WS_GB : WS_GA)); h16* H = (h16*)(ws + WS_H);
#pragma unroll
        for (int ai = 0; ai < 2; ++ai)
#pragma unroll
            for (int m = 0; m < 4; ++m) { const size_t off = (size_t)(row0 + ai * 128 + m * 16) * DM + col0;
#pragma unroll
                for (int bj = 0; bj < 2; ++bj) { f32x4 g0, g1; unpack8(*(const u32x4*)(gt + off + bj * 128), g0, g1);
                    f32x4 v0 = acc[ai][bj][m][0] * g0, v1 = acc[ai][bj][m][1] * g1;
                    if (second) { f32x4 p0, p1; unpack8(*(const u32x4*)(H + off + bj * 128), p0, p1); v0 += p0; v1 += p1; }
                    *(u32x4*)(H + off + bj * 128) = pack8(v0, v1); } }
    }
};
struct EpiOut {
    static constexpr bool PERM = false;
    const float* x; float* out;
    __device__ __forceinline__ void operator()(const f32x4 (&acc)[2][2][4][2], const Unit& u, int wr, int wc, int fr, int fq) const {
        const int row0 = u.pm * 256 + wr * 64 + fr, col0 = u.pn * 256 + wc * 32 + 4 * fq;
#pragma unroll
        for (int ai = 0; ai < 2; ++ai)
#pragma unroll
            for (int m = 0; m < 4; ++m) { const size_t off = (size_t)(row0 + ai * 128 + m * 16) * DM + col0;
#pragma unroll
                for (int bj = 0; bj < 2; ++bj)
#pragma unroll
                    for (int n = 0; n < 2; ++n) { const f32x4 xv = *(const f32x4*)(x + off + bj * 128 + n * 16); *(f32x4*)(out + off + bj * 128 + n * 16) = xv + acc[ai][bj][m][n]; } }
    }
};
struct EpiAct {
    static constexpr bool PERM = true;
    h16* act;
    __device__ __forceinline__ void operator()(const f32x4 (&acc)[2][2][4][2], const Unit& u, int wr, int wc, int fr, int fq) const {
        const int r0 = wr * 64 + fr; const int col0 = u.pn * 128 + wc * 32 + 8 * fq;
#pragma unroll
        for (int ai = 0; ai < 2; ++ai)
#pragma unroll
            for (int m = 0; m < 4; ++m) { const int r = r0 + ai * 128 + m * 16; const float w = r < u.nrows ? u.wl[r] : 0.f;
                f32x4 v0, v1;
#pragma unroll
                for (int j = 0; j < 4; ++j) { const float g0 = acc[ai][0][m][0][j], g1 = acc[ai][0][m][1][j];
                    v0[j] = g0 * sigmoidf_(g0) * acc[ai][1][m][0][j] * w; v1[j] = g1 * sigmoidf_(g1) * acc[ai][1][m][1][j] * w; }
                *(u32x4*)(act + (size_t)(u.pm * 256 + r) * DEXP + col0) = pack8(v0, v1); }
    }
};
struct EpiY {
    static constexpr bool PERM = true;
    h16* y;
    __device__ __forceinline__ void operator()(const f32x4 (&acc)[2][2][4][2], const Unit& u, int wr, int wc, int fr, int fq) const {
        const int row0 = u.pm * 256 + wr * 64 + fr, col0 = u.pn * 256 + wc * 32 + 8 * fq;
#pragma unroll
        for (int ai = 0; ai < 2; ++ai)
#pragma unroll
            for (int m = 0; m < 4; ++m) { h16* rowp = y + (size_t)(row0 + ai * 128 + m * 16) * DM + col0;
#pragma unroll
                for (int bj = 0; bj < 2; ++bj) *(u32x4*)(rowp + bj * 128) = pack8(acc[ai][bj][m][0], acc[ai][bj][m][1]); }
    }
};

constexpr float SB_EXIT = 104.0f;
__device__ __forceinline__ void attn_task(int b, int h, int qblk, h16* Q, const h16* Kb, const h16* VT, int lane) {
    const int r = lane & 31, hh = lane >> 5;
    const size_t tb = (size_t)b * SEQ;
    h16* qrow = Q + (tb + qblk * 32 + r) * AW + h * HD + 8 * hh;
    h16x8 bq[4];
#pragma unroll
    for (int s = 0; s < 4; ++s) bq[s] = *(const h16x8*)(qrow + 16 * s);
    f32x16 o0 = {}, o1 = {}; float run = 0.f;
    const h16* kbase = Kb + (tb + r) * AW + h * HD + 8 * hh;
    const h16* vbase = VT + ((size_t)(b * NH + h) * HD + r) * SEQ + 8 * hh;
    h16x8 ak[4], av[2][2];
#pragma unroll
    for (int s = 0; s < 4; ++s) ak[s] = *(const h16x8*)(kbase + (size_t)(qblk * 32) * AW + 16 * s);
#pragma unroll
    for (int db = 0; db < 2; ++db)
#pragma unroll
        for (int s2 = 0; s2 < 2; ++s2) av[db][s2] = *(const h16x8*)(vbase + (size_t)(32 * db) * SEQ + qblk * 32 + 16 * s2);
    for (int kt = qblk; kt >= 0; --kt) {
        const int ktn = kt > 0 ? kt - 1 : 0;
        h16x8 akn[4], avn[2][2];
#pragma unroll
        for (int s = 0; s < 4; ++s) akn[s] = *(const h16x8*)(kbase + (size_t)(ktn * 32) * AW + 16 * s);
#pragma unroll
        for (int db = 0; db < 2; ++db)
#pragma unroll
            for (int s2 = 0; s2 < 2; ++s2) avn[db][s2] = *(const h16x8*)(vbase + (size_t)(32 * db) * SEQ + ktn * 32 + 16 * s2);
        f32x16 p = {};
#pragma unroll
        for (int s = 0; s < 4; ++s) p = __builtin_amdgcn_mfma_f32_32x32x16_f16(ak[s], bq[s], p, 0, 0, 0);
        const bool diag = (kt == qblk);
        float sp[16];
#pragma unroll
        for (int i = 0; i < 16; ++i) { const float z = p[i]; float v = fmaxf(z, 0.f) + __logf(1.0f + __expf(-fabsf(z)));
            if (diag) { const int key = (i & 3) + 8 * (i >> 2) + 4 * hh; v = key < r ? v : 0.f; }
            sp[i] = v; }
        float G[4], Go[4], T[4];
#pragma unroll
        for (int g = 0; g < 4; ++g) { G[g] = (sp[4 * g] + sp[4 * g + 1]) + (sp[4 * g + 2] + sp[4 * g + 3]); Go[g] = __shfl_xor(G[g], 32); T[g] = G[g] + Go[g]; }
        float base[4];
        base[3] = run; base[2] = run + T[3]; base[1] = base[2] + T[2]; base[0] = base[1] + T[1];
        float a[16];
#pragma unroll
        for (int g = 0; g < 4; ++g) { float t = base[g] + (hh == 0 ? Go[g] : 0.f);
#pragma unroll
            for (int w = 3; w >= 0; --w) { const int i = 4 * g + w; float e = __expf(p[i] - sp[i] - t);
                if (diag) { const int key = (i & 3) + 8 * (i >> 2) + 4 * hh; e = key < r ? e : 0.f; }
                a[i] = e; t += sp[i]; } }
        run = base[0] + T[0];
        h16x8 bp0, bp1;
#pragma unroll
        for (int j = 0; j < 8; ++j) { bp0[j] = (h16)a[j]; bp1[j] = (h16)a[8 + j]; }
        o0 = __builtin_amdgcn_mfma_f32_32x32x16_f16(av[0][0], bp0, o0, 0, 0, 0);
        o0 = __builtin_amdgcn_mfma_f32_32x32x16_f16(av[0][1], bp1, o0, 0, 0, 0);
        o1 = __builtin_amdgcn_mfma_f32_32x32x16_f16(av[1][0], bp0, o1, 0, 0, 0);
        o1 = __builtin_amdgcn_mfma_f32_32x32x16_f16(av[1][1], bp1, o1, 0, 0, 0);
        if (__all(run > SB_EXIT)) break;
#pragma unroll
        for (int s = 0; s < 4; ++s) ak[s] = akn[s];
#pragma unroll
        for (int db = 0; db < 2; ++db)
#pragma unroll
            for (int s2 = 0; s2 < 2; ++s2) av[db][s2] = avn[db][s2];
    }
    h16* orow = Q + (tb + qblk * 32 + r) * AW + h * HD + 4 * hh;
#pragma unroll
    for (int g = 0; g < 4; ++g) {
        u32x2 w0; w0.x = pkh(o0[4 * g], o0[4 * g + 1]); w0.y = pkh(o0[4 * g + 2], o0[4 * g + 3]); *(u32x2*)(orow + 8 * g) = w0;
        u32x2 w1; w1.x = pkh(o1[4 * g], o1[4 * g + 1]); w1.y = pkh(o1[4 * g + 2], o1[4 * g + 3]); *(u32x2*)(orow + 32 + 8 * g) = w1; }
}
__device__ __forceinline__ void p2_attn_conv(Frame& F) {
    const int gw = F.vcu * 8 + F.wave, NGW = F.G * 8, lane = F.lane;
    h16* Q = (h16*)(F.ws + WS_Q); const h16* Kb = (const h16*)(F.ws + WS_K); const h16* VT = (const h16*)(F.ws + WS_VT);
    for (int t = gw; t < 32 * 64; t += NGW) { const int bh = t >> 6, j = t & 63;
        attn_task(bh >> 3, bh & 7, 127 - j, Q, Kb, VT, lane);
        attn_task(bh >> 3, bh & 7, j, Q, Kb, VT, lane); }
    h16* CB = (h16*)(F.ws + WS_CB); const h16* CC = (const h16*)(F.ws + WS_CC); const h16* CU = (const h16*)(F.ws + WS_CU); const float* cw = F.in[5];
    f32x4 w0a = *(const f32x4*)(cw + 8 * lane), w0b = *(const f32x4*)(cw + 8 * lane + 4), w1a = *(const f32x4*)(cw + AW + 8 * lane), w1b = *(const f32x4*)(cw + AW + 8 * lane + 4),
          w2a = *(const f32x4*)(cw + 2 * AW + 8 * lane), w2b = *(const f32x4*)(cw + 2 * AW + 8 * lane + 4);
    for (int c = gw; c < NTOK / 8; c += NGW) { const int t0 = c * 8; const bool first = (t0 & (SEQ - 1)) == 0;
        f32x4 pa2 = {}, pb2 = {}, pa1 = {}, pb1 = {};
        if (!first) { f32x4 x0, x1, y0, y1;
            unpack8(*(const u32x4*)(CC + (size_t)(t0 - 2) * AW + 8 * lane), x0, x1); unpack8(*(const u32x4*)(CU + (size_t)(t0 - 2) * AW + 8 * lane), y0, y1); pa2 = x0 * y0; pb2 = x1 * y1;
            unpack8(*(const u32x4*)(CC + (size_t)(t0 - 1) * AW + 8 * lane), x0, x1); unpack8(*(const u32x4*)(CU + (size_t)(t0 - 1) * AW + 8 * lane), y0, y1); pa1 = x0 * y0; pb1 = x1 * y1; }
#pragma unroll
        for (int i = 0; i < 8; ++i) { const size_t off = (size_t)(t0 + i) * AW + 8 * lane; f32x4 x0, x1, y0, y1, b0, b1;
            unpack8(*(const u32x4*)(CC + off), x0, x1); unpack8(*(const u32x4*)(CU + off), y0, y1); unpack8(*(const u32x4*)(CB + off), b0, b1);
            const f32x4 pa0 = x0 * y0, pb0 = x1 * y1;
            const f32x4 ya = b0 * (w0a * pa2 + w1a * pa1 + w2a * pa0), yb = b1 * (w0b * pb2 + w1b * pb1 + w2b * pb0);
            *(u32x4*)(CB + off) = pack8(ya, yb);
            pa2 = pa1; pb2 = pb1; pa1 = pa0; pb1 = pb0; } }
}

__device__ __forceinline__ void p5_router(Frame& F) {
    const int gw = F.vcu * 8 + F.wave, NGW = F.G * 8, lane = F.lane;
    LAS float* RW = (LAS float*)F.lds;
    { const f32x4* src = (const f32x4*)(F.ws + WS_RW); LAS f32x4* dst = (LAS f32x4*)F.lds;
      for (int i = F.tid; i < 36 * 1024 / 4; i += 512) dst[i] = src[i]; }
    __syncthreads();
    const float* g2 = F.in[9]; const float* bg = F.in[11]; const float* be = F.in[13];
    h16* H = (h16*)(F.ws + WS_H); int* TOK = (int*)(F.ws + WS_TOK); float* WL = (float*)(F.ws + WS_WL); i32x4* ROUTE = (i32x4*)(F.ws + WS_ROUTE);
    f32x4 gv[4];
#pragma unroll
    for (int j = 0; j < 4; ++j) gv[j] = ((const f32x4*)g2)[lane + 64 * j];
    for (int m = gw; m < NTOK; m += NGW) {
        const f32x4* xr = (const f32x4*)(F.out + (size_t)m * DM) + lane;
        f32x4 v[4]; float s = 0.f;
#pragma unroll
        for (int j = 0; j < 4; ++j) { v[j] = xr[64 * j]; s += (v[j].x * v[j].x + v[j].y * v[j].y) + (v[j].z * v[j].z + v[j].w * v[j].w); }
        const float rstd = rsqrtf(wave_sum(s) * (1.f / DM) + EPS);
        u32x2* o8 = (u32x2*)(H + (size_t)m * DM) + lane;
#pragma unroll
        for (int j = 0; j < 4; ++j) { const f32x4 y = v[j] * rstd * gv[j]; u32x2 w; w.x = pkh(y.x, y.y); w.y = pkh(y.z, y.w); o8[64 * j] = w; }
        float lg[4];
#pragma unroll
        for (int c = 0; c < 4; ++c) { float a = 0.f;
#pragma unroll
            for (int j = 0; j < 4; ++j) { const f32x4 w = *(const LAS f32x4*)(RW + c * 1024 + 256 * j + 4 * lane); a += (v[j].x * w.x + v[j].y * w.y) + (v[j].z * w.z + v[j].w * w.w); }
            lg[c] = wave_sum(a) * rstd + bg[c]; }
        int gi = 0; float gm = lg[0];
#pragma unroll
        for (int c = 1; c < 4; ++c) if (lg[c] > gm) { gm = lg[c]; gi = c; }
        gi = __builtin_amdgcn_readfirstlane(gi);
        float den = 0.f;
#pragma unroll
        for (int c = 0; c < 4; ++c) den += __expf(lg[c] - gm);
        const float gwt = 1.0f / den;
        float ev[8];
        { const LAS float* rw = RW + (4 + 8 * gi) * 1024 + 4 * lane; const float* bp = be + 8 * gi;
#pragma unroll
          for (int c = 0; c < 8; ++c) { float a = 0.f;
#pragma unroll
            for (int j = 0; j < 4; ++j) { const f32x4 w = *(const LAS f32x4*)(rw + c * 1024 + 256 * j); a += (v[j].x * w.x + v[j].y * w.y) + (v[j].z * w.z + v[j].w * w.w); }
            ev[c] = wave_sum(a) * rstd + bp[c]; } }
        int i0 = 0; float v0 = ev[0];
#pragma unroll
        for (int c = 1; c < 8; ++c) if (ev[c] > v0) { v0 = ev[c]; i0 = c; }
        int i1 = -1; float v1 = -INFINITY;
#pragma unroll
        for (int c = 0; c < 8; ++c) if (c != i0 && ev[c] > v1) { v1 = ev[c]; i1 = c; }
        const float e1 = __expf(v1 - v0), w0 = gwt / (1.0f + e1), w1 = gwt * e1 / (1.0f + e1);
        if (lane == 0) {
            const int e0 = gi * 8 + i0, e1i = gi * 8 + i1;
            const int p0 = (int)atomicAdd(F.ctl + CW_CNT + 64 * e0, 1u), p1 = (int)atomicAdd(F.ctl + CW_CNT + 64 * e1i, 1u);
            TOK[(size_t)e0 * LCAP + p0] = m; WL[(size_t)e0 * LCAP + p0] = w0; TOK[(size_t)e1i * LCAP + p1] = m; WL[(size_t)e1i * LCAP + p1] = w1;
            ROUTE[m] = (i32x4){e0, p0, e1i, p1};
        }
    }
}
__device__ __forceinline__ void load_counts(Frame& F) {
    __syncthreads();
    if (F.tid < NEXP) F.MISC[64 + F.tid] = __hip_atomic_load(F.ctl + CW_CNT + 64 * F.tid, __ATOMIC_RELAXED, __HIP_MEMORY_SCOPE_AGENT);
    __syncthreads();
}
__device__ __forceinline__ void p8_combine(Frame& F) {
    const int gw = F.vcu * 8 + F.wave, NGW = F.G * 8, lane = F.lane;
    const LAS int* cntl = (const LAS int*)(F.MISC + 64);
    const h16* Y = (const h16*)(F.ws + WS_Y); const i32x4* ROUTE = (const i32x4*)(F.ws + WS_ROUTE);
    for (int m = gw; m < NTOK; m += NGW) {
        const i32x4 rt = ROUTE[m];
        int b0 = 0, b1 = 0, acc = 0;
        for (int j = 0; j < NEXP; ++j) { if (j == rt.x) b0 = acc; if (j == rt.z) b1 = acc; acc += ((cntl[j] + 255) >> 8) << 8; }
        const size_t r0 = (size_t)(b0 + rt.y), r1 = (size_t)(b1 + rt.w);
        f32x4* xr = (f32x4*)(F.out + (size_t)m * DM) + lane;
        const u32x2* y0 = (const u32x2*)(Y + r0 * DM) + lane; const u32x2* y1 = (const u32x2*)(Y + r1 * DM) + lane;
#pragma unroll
        for (int j = 0; j < 4; ++j) { f32x4 v = xr[64 * j]; const h16x4 a = __builtin_bit_cast(h16x4, y0[64 * j]), b = __builtin_bit_cast(h16x4, y1[64 * j]);
            v.x += (float)a[0] + (float)b[0]; v.y += (float)a[1] + (float)b[1]; v.z += (float)a[2] + (float)b[2]; v.w += (float)a[3] + (float)b[3]; xr[64 * j] = v; }
    }
}

__global__ void __launch_bounds__(512, 2) hsb_fwd(Args args) {
    extern __shared__ __attribute__((aligned(16))) unsigned char lds[];
    Frame F;
    F.lds = (LAS unsigned char*)lds; F.MISC = (volatile LAS unsigned*)(F.lds + MISC_OFF);
    F.tid = threadIdx.x; F.lane = F.tid & 63; F.wave = __builtin_amdgcn_readfirstlane(F.tid >> 6);
    F.G = gridDim.x; { const int bx = blockIdx.x; F.vcu = (F.G % 8 == 0) ? (bx % 8) * (F.G / 8) + bx / 8 : bx; }
#pragma unroll
    for (int i = 0; i < 17; ++i) F.in[i] = args.in[i];
    F.out = args.out; F.ws = args.ws; F.ctl = (unsigned*)(args.ws + WS_CTL);
    for (int u = F.tid; u < 256; u += 512) ((LAS unsigned*)(F.lds + MISC_OFF))[u] = 0u;
    __syncthreads();
    XcdBarrier bar; bar.bar = F.ctl + CW_BAR; bar.x = 0; bar.st = nullptr;
    if (MK_N_LAUNCHES == 1) bar = xcd_barrier_post(F.ctl + CW_BAR, F.MISC + 8);
    const int lo = args.ph_lo, hi = args.ph_hi;
#ifndef PH_MASK
#define PH_MASK 0x1ff
#endif
#define IN(k) (((PH_MASK >> (k)) & 1) && lo <= (k) && (k) < hi)
#define SEAM(k) do { if (IN(k) && IN((k) + 1)) xcd_barrier(bar); } while (0)
    unsigned char* ws = args.ws;

    if (IN(0)) { p0_prologue(F); } SEAM(0);
    if (IN(1)) {
        StaticOrder S{(const char*)(ws + WS_H), (const char*)(ws + WS_WIN), NTOK / 256, NPROJ / 256, F.G, (int)blockIdx.x, (size_t)256 * DM * 2};
        EpiProj E{ws, F.in[3], F.in[4]};
        pg8::gemm_phase<EpiProj, StaticOrder, false>(F.lds, DM, S, E);
    } SEAM(1);
    if (IN(2)) { p2_attn_conv(F); } SEAM(2);
    if (IN(3)) {
        BranchOrder S{(const char*)(ws + WS_Q), (const char*)(ws + WS_CB), (const char*)(ws + WS_WSB), (const char*)(ws + WS_WCV), F.G, (int)blockIdx.x};
        EpiBranch E{ws};
        pg8::gemm_phase<EpiBranch, BranchOrder, false>(F.lds, AW, S, E);
    } SEAM(3);
    if (IN(4)) {
        StaticOrder S{(const char*)(ws + WS_H), (const char*)(ws + WS_WOUT), NTOK / 256, DM / 256, F.G, (int)blockIdx.x, (size_t)256 * DM * 2};
        EpiOut E{F.in[0], F.out};
        pg8::gemm_phase<EpiOut, StaticOrder, false>(F.lds, DM, S, E);
    } SEAM(4);
    if (IN(5)) { p5_router(F); } SEAM(5);
    if (IN(6)) {
        load_counts(F);
        MoeOrder<2, true> S{(const LAS int*)(F.MISC + 64), (const char*)(ws + WS_H), (const char*)(ws + WS_W1), (const int*)(ws + WS_TOK), (const float*)(ws + WS_WL), F.G, (int)blockIdx.x};
        EpiAct E{(h16*)(ws + WS_ACT)};
        pg8::gemm_phase<EpiAct, MoeOrder<2, true>, true>(F.lds, DM, S, E);
    } SEAM(6);
    if (IN(7)) {
        load_counts(F);
        MoeOrder<4, false> S{(const LAS int*)(F.MISC + 64), (const char*)(ws + WS_ACT), (const char*)(ws + WS_W2), (const int*)(ws + WS_TOK), (const float*)(ws + WS_WL), F.G, (int)blockIdx.x};
        EpiY E{(h16*)(ws + WS_Y)};
        pg8::gemm_phase<EpiY, MoeOrder<4, false>, false>(F.lds, DEXP, S, E);
    } SEAM(7);
    if (IN(8)) { load_counts(F); p8_combine(F); }
#undef IN
#undef SEAM
}

extern "C" void kernel_launch(void* const* d_in, const int* in_sizes, int n_in, void* d_out, int out_size, void* d_ws, size_t ws_size, hipStream_t stream) {
    static int grid = 0;
    if (grid == 0) {
        if (n_in != 17 || in_sizes[0] != NTOK * DM || out_size != NTOK * DM || ws_size < WS_END) {
            fprintf(stderr, "kernel_launch: unexpected problem: n_in %d in0 %d out %d ws %zu; nothing launched\n", n_in, n_in > 0 ? in_sizes[0] : -1, out_size, ws_size); grid = -1; return; }
        int dev = 0, cus = 0, per_cu = 0;
        if (hipGetDevice(&dev) != hipSuccess || hipDeviceGetAttribute(&cus, hipDeviceAttributeMultiprocessorCount, dev) != hipSuccess) { fprintf(stderr, "kernel_launch: device query failed\n"); grid = -1; return; }
        if (hipFuncSetAttribute((const void*)hsb_fwd, hipFuncAttributeMaxDynamicSharedMemorySize, LDS_BYTES) != hipSuccess) { fprintf(stderr, "kernel_launch: hipFuncSetAttribute failed\n"); grid = -1; return; }
        if (hipOccupancyMaxActiveBlocksPerMultiprocessor(&per_cu, (const void*)hsb_fwd, 512, LDS_BYTES) != hipSuccess || per_cu < 1) {
            fprintf(stderr, "kernel_launch: occupancy query reports %d workgroups per CU\n", per_cu); (void)hipGetLastError(); per_cu = 1; }
        grid = cus;
    }
    if (grid < 0) return;
    (void)hipMemsetAsync((char*)d_ws + WS_CTL, 0, CTL_BYTES, stream);
    Args a{};
    for (int i = 0; i < 17; ++i) a.in[i] = (const float*)d_in[i];
    a.out = (float*)d_out; a.ws = (unsigned char*)d_ws;
    if (MK_N_LAUNCHES == 1) { a.ph_lo = 0; a.ph_hi = N_PHASES; hipLaunchKernelGGL(hsb_fwd, dim3(grid), dim3(512), LDS_BYTES, stream, a); }
    else { for (int p = 0; p < N_PHASES; ++p) { a.ph_lo = p; a.ph_hi = p + 1; hipLaunchKernelGGL(hsb_fwd, dim3(grid), dim3(512), LDS_BYTES, stream, a); } }
}
```

```cpp
#include <hip/hip_runtime.h>
#include <cstdio>
#include <cstdint>

#define LAS __attribute__((address_space(3)))
#define GAS __attribute__((address_space(1)))
typedef _Float16 h16;
typedef h16 h16x8 __attribute__((ext_vector_type(8)));
typedef h16 h16x4 __attribute__((ext_vector_type(4)));
typedef h16 h16x2 __attribute__((ext_vector_type(2)));
typedef float f32x2 __attribute__((ext_vector_type(2)));
typedef float f32x4 __attribute__((ext_vector_type(4)));
typedef float f32x16 __attribute__((ext_vector_type(16)));
typedef unsigned u32x2 __attribute__((ext_vector_type(2)));
typedef unsigned u32x4 __attribute__((ext_vector_type(4)));
typedef int i32x4 __attribute__((ext_vector_type(4)));

#ifndef MK_N_LAUNCHES
#define MK_N_LAUNCHES 1
#endif
constexpr int N_PHASES = 9;

constexpr int NTOK = 16384, SEQ = 4096, DM = 1024, NH = 8, HD = 64, AW = 512, NPROJ = 5120, NEXP = 32, DEXP = 256;
constexpr float EPS = 1e-6f;
constexpr int LCAP = 16384;
constexpr size_t MiB = 1u << 20;
constexpr size_t WS_CTL = 0, CTL_BYTES = 256 * 1024;
constexpr size_t WS_RW = 512 * 1024;
constexpr size_t WS_WIN = 1 * MiB, WS_WSB = 11 * MiB, WS_WCV = 12 * MiB, WS_WOUT = 13 * MiB, WS_W1 = 15 * MiB, WS_W2 = 47 * MiB;
constexpr size_t WS_H = 63 * MiB;
constexpr size_t WS_Q = 95 * MiB, WS_K = 111 * MiB, WS_VT = 127 * MiB, WS_CB = 143 * MiB, WS_CC = 159 * MiB, WS_CU = 175 * MiB, WS_GA = 191 * MiB, WS_GB = 223 * MiB;
constexpr size_t WS_AO = WS_H, WS_CO = WS_H + 16 * MiB;
constexpr size_t WS_MRG = WS_Q;
constexpr size_t WS_ACT = WS_Q;
constexpr size_t WS_Y = WS_VT;
constexpr size_t WS_TOK = WS_GB, WS_WL = WS_GB + 2 * MiB, WS_ROUTE = WS_GB + 4 * MiB;
constexpr size_t WS_END = 256 * MiB;
constexpr int CW_CNT = 64;
constexpr int CW_BAR = 8192;

constexpr int RING_BYTES = 131072;
constexpr int SCR_BYTES = 147456;
constexpr int MISC_OFF = SCR_BYTES;
constexpr int LDS_BYTES = SCR_BYTES + 1024;

#define LDS_WAIT() asm volatile("s_waitcnt lgkmcnt(0)" ::: "memory")
#define VM_WAIT() asm volatile("s_waitcnt vmcnt(0)" ::: "memory")

__device__ __forceinline__ unsigned pkh(float lo, float hi) { f32x2 v = {lo, hi}; h16x2 b = __builtin_convertvector(v, h16x2); return __builtin_bit_cast(unsigned, b); }
__device__ __forceinline__ float wave_sum(float v) {
#pragma unroll
    for (int o = 1; o < 64; o <<= 1) v += __shfl_xor(v, o);
    return v;
}
template <int CTRL, int ROWMASK> __device__ __forceinline__ float dpp_mov(float v) { return __builtin_bit_cast(float, __builtin_amdgcn_update_dpp(0, __builtin_bit_cast(int, v), CTRL, ROWMASK, 0xf, false)); }
__device__ __forceinline__ float row_sum16(float v) {
    v += dpp_mov<0xB1, 0xf>(v); v += dpp_mov<0x4E, 0xf>(v); v += dpp_mov<0x141, 0xf>(v); v += dpp_mov<0x140, 0xf>(v); return v;
}
__device__ __forceinline__ float wave_total(float v) {
    v = row_sum16(v);
    v += dpp_mov<0x142, 0xa>(v);
    v += dpp_mov<0x143, 0xc>(v);
    return __builtin_bit_cast(float, __builtin_amdgcn_readlane(__builtin_bit_cast(int, v), 63));
}
__device__ __forceinline__ float sigmoidf_(float x) { return __builtin_amdgcn_rcpf(1.0f + __expf(-x)); }

namespace pg8 {
constexpr int BM = 256, BK = 64, HALF = 128, HTB = HALF * BK * 2, NXCD = 8, WGM = 8;
__device__ __forceinline__ int lds_byte(int r, int c) { const int st = (r >> 4) * 2 + (c >> 5), rr = r & 15, cc = c & 31, ob = rr * 64 + cc * 2; return st * 1024 + (ob ^ (((ob >> 9) & 1) << 5)); }
__device__ __forceinline__ void stage_rc(int b, int& R, int& C) { const int st = b / 1024, sb = b % 1024, swz = sb ^ (((sb >> 9) & 1) << 5); R = (st >> 1) * 16 + swz / 64; C = (st & 1) * 32 + (swz % 64) / 2; }
__device__ __forceinline__ int perm32(int rho) { const int n = rho >> 4, i = rho & 15; return 8 * (i >> 2) + 4 * n + (i & 3); }

struct Unit { const char* a; const char* b; const int* lst; const float* wl; int pm, pn, e, nrows; };

__device__ __forceinline__ void tile_of(int L, int nM, int nN, int& pm, int& pn) {
    const int nwg = nM * nN; int wgid = L; { const int q = nwg / NXCD, r = nwg % NXCD, xcd = wgid % NXCD, off = wgid / NXCD; wgid = (xcd < r ? xcd * (q + 1) : r * (q + 1) + (xcd - r) * q) + off; }
    const int nig = WGM * nN, gid = wgid / nig, fm = gid * WGM, gsz = (nM - fm) < WGM ? (nM - fm) : WGM;
    pm = fm + ((wgid % nig) % gsz); pn = (wgid % nig) / gsz;
}

template <class Epi, class Sched, bool GATHER>
__device__ __forceinline__ void gemm_phase(LAS unsigned char* lds, const int K, const Sched& S, const Epi& E) {
    const int tid = threadIdx.x, wid = __builtin_amdgcn_readfirstlane(tid >> 6), lane = tid & 63, wr = wid >> 2, wc = wid & 3, fr = lane & 15, fq = lane >> 4;
    const int nt = K / BK;
    unsigned voffA[2], voffB[2]; int RA[2], CA[2];
#pragma unroll
    for (int i = 0; i < 2; ++i) { int R, C; stage_rc(tid * 16 + i * 8192, R, C); const int Rb = Epi::PERM ? ((R & ~31) + perm32(R & 31)) : R;
        RA[i] = R; CA[i] = C; voffA[i] = (unsigned)(R * K + C) * 2u; voffB[i] = (unsigned)(Rb * K + C) * 2u; }
    const size_t kstep = (size_t)(BK * 2);
    const size_t hstep = (size_t)HALF * K * 2;
    const unsigned ldsw = (unsigned)wid * 1024u;
    const int aoff = lds_byte(wr * 64 + fr, fq * 8), boff = lds_byte(wc * 32 + fr, fq * 8);
#define PG8_SA(b, h) (((b) * 2 + (h)) * HTB)
#define PG8_SB(b, h) ((4 + (b) * 2 + (h)) * HTB)
#define PG8_GLDS(bufoff, gptr, i) __builtin_amdgcn_global_load_lds((const unsigned*)(gptr), (LAS unsigned*)(lds + (bufoff) + ldsw + (i) * 8192), 16, 0, 0)
#define PG8_STAGE_B(bufoff, gbase, h) do { PG8_GLDS(bufoff, (const char*)(gbase) + (h) * hstep + voffB[0], 0); PG8_GLDS(bufoff, (const char*)(gbase) + (h) * hstep + voffB[1], 1); } while (0)
#define PG8_STAGE_A(bufoff, gbase, h, v0, v1) do { if constexpr (GATHER) { PG8_GLDS(bufoff, (const char*)(gbase) + (v0), 0); PG8_GLDS(bufoff, (const char*)(gbase) + (v1), 1); } \
        else { PG8_GLDS(bufoff, (const char*)(gbase) + (h) * hstep + voffA[0], 0); PG8_GLDS(bufoff, (const char*)(gbase) + (h) * hstep + voffA[1], 1); } } while (0)
#define PG8_LDA(dst, b, h) do { _Pragma("unroll") for (int m = 0; m < 4; ++m) _Pragma("unroll") for (int k = 0; k < 2; ++k) dst[m][k] = *(const LAS h16x8*)(lds + PG8_SA(b, h) + aoff + m * 2048 + k * 1024); } while (0)
#define PG8_LDB(dst, b, h) do { _Pragma("unroll") for (int n = 0; n < 2; ++n) _Pragma("unroll") for (int k = 0; k < 2; ++k) dst[n][k] = *(const LAS h16x8*)(lds + PG8_SB(b, h) + boff + n * 2048 + k * 1024); } while (0)
#define PG8_MMA(ai, bj, At, Bt) do { __builtin_amdgcn_s_setprio(1); _Pragma("unroll") for (int m = 0; m < 4; ++m) _Pragma("unroll") for (int n = 0; n < 2; ++n) _Pragma("unroll") for (int k = 0; k < 2; ++k) \
        acc[ai][bj][m][n] = __builtin_amdgcn_mfma_f32_16x16x32_f16(Bt[n][k], At[m][k], acc[ai][bj][m][n], 0, 0, 0); __builtin_amdgcn_s_setprio(0); } while (0)
#define PG8_WAIT_V(n) asm volatile("s_waitcnt vmcnt(" #n ")" ::: "memory")
#define PG8_WAIT_L(n) asm volatile("s_waitcnt lgkmcnt(" #n ")" ::: "memory")
#define PG8_BAR __builtin_amdgcn_s_barrier()
#define PG8_SCHED __builtin_amdgcn_sched_barrier(0)
    Unit cur, nxt; int ui = 0;
    if (!S.next(0, cur)) return;
    f32x4 acc[2][2][4][2];
#pragma unroll
    for (int a = 0; a < 2; ++a)
#pragma unroll
        for (int b = 0; b < 2; ++b)
#pragma unroll
            for (int m = 0; m < 4; ++m)
#pragma unroll
                for (int n = 0; n < 2; ++n) acc[a][b][m][n] = (f32x4){0.f, 0.f, 0.f, 0.f};
    h16x8 At[4][2], B0[2][2], B1[2][2];
    const char* cA = cur.a; const char* cB = cur.b;
    unsigned gc00 = 0, gc01 = 0, gc10 = 0, gc11 = 0, gn00 = 0, gn01 = 0, gn10 = 0, gn11 = 0;
#define PG8_GOFF(u, h, i) ((unsigned)(S.tok(u, (h) * HALF + RA[i]) * K + CA[i]) * 2u)
    if constexpr (GATHER) { gc00 = PG8_GOFF(cur, 0, 0); gc01 = PG8_GOFF(cur, 0, 1); gc10 = PG8_GOFF(cur, 1, 0); gc11 = PG8_GOFF(cur, 1, 1); }
    PG8_STAGE_B(PG8_SB(0, 0), cB, 0); PG8_STAGE_B(PG8_SB(0, 1), cB, 1); PG8_STAGE_A(PG8_SA(0, 0), cA, 0, gc00, gc01); PG8_STAGE_A(PG8_SA(0, 1), cA, 1, gc10, gc11);
    if (wr == 1) PG8_BAR;
    PG8_WAIT_V(2); PG8_BAR;
    PG8_STAGE_B(PG8_SB(1, 0), cB + kstep, 0); PG8_STAGE_A(PG8_SA(1, 0), cA + kstep, 0, gc00, gc01); PG8_STAGE_B(PG8_SB(1, 1), cB + kstep, 1);
    PG8_WAIT_V(6); PG8_BAR;
    for (;;) {
        const bool has_next = S.next(ui + 1, nxt);
        const char* nA = has_next ? nxt.a : cA; const char* nB = has_next ? nxt.b : cB;
        if constexpr (GATHER) { if (has_next) { gn00 = PG8_GOFF(nxt, 0, 0); gn01 = PG8_GOFF(nxt, 0, 1); gn10 = PG8_GOFF(nxt, 1, 0); gn11 = PG8_GOFF(nxt, 1, 1); } else { gn00 = gc00; gn01 = gc01; gn10 = gc10; gn11 = gc11; } }
#pragma unroll 1
        for (int t = 0; t < nt; t += 2) {
            const bool last = (t == nt - 2);
            const char* a1 = cA + (size_t)(t + 1) * kstep;
            const char* a2 = last ? nA : cA + (size_t)(t + 2) * kstep; const char* b2 = last ? nB : cB + (size_t)(t + 2) * kstep;
            const char* a3 = a2 + kstep; const char* b3 = b2 + kstep;
            unsigned s00 = gc00, s01 = gc01, s10 = gc10, s11 = gc11;
            if constexpr (GATHER) { if (last) { s00 = gn00; s01 = gn01; s10 = gn10; s11 = gn11; } }
            PG8_LDB(B0, 0, 0); PG8_LDB(B1, 0, 1); PG8_SCHED; PG8_LDA(At, 0, 0); PG8_STAGE_A(PG8_SA(1, 1), a1, 1, gc10, gc11);
            PG8_WAIT_V(8); PG8_WAIT_L(0); PG8_BAR; PG8_MMA(0, 0, At, B0); PG8_MMA(0, 1, At, B1); PG8_BAR; PG8_SCHED;
            PG8_LDA(At, 0, 1); PG8_STAGE_B(PG8_SB(0, 0), b2, 0); PG8_STAGE_B(PG8_SB(0, 1), b2, 1); PG8_STAGE_A(PG8_SA(0, 0), a2, 0, s00, s01);
            PG8_WAIT_V(8); PG8_WAIT_L(0); PG8_BAR; PG8_MMA(1, 0, At, B0); PG8_MMA(1, 1, At, B1); PG8_BAR; PG8_SCHED;
            PG8_LDB(B0, 1, 0); PG8_LDB(B1, 1, 1); PG8_SCHED; PG8_LDA(At, 1, 0); PG8_STAGE_A(PG8_SA(0, 1), a2, 1, s10, s11);
            PG8_WAIT_V(8); PG8_WAIT_L(0); PG8_BAR; PG8_MMA(0, 0, At, B0); PG8_MMA(0, 1, At, B1); PG8_BAR; PG8_SCHED;
            PG8_LDA(At, 1, 1); PG8_STAGE_B(PG8_SB(1, 0), b3, 0); PG8_STAGE_B(PG8_SB(1, 1), b3, 1); PG8_STAGE_A(PG8_SA(1, 0), a3, 0, s00, s01);
            PG8_WAIT_V(8); PG8_WAIT_L(0); PG8_BAR; PG8_MMA(1, 0, At, B0); PG8_MMA(1, 1, At, B1); PG8_BAR; PG8_SCHED;
        }
        if (wr == 0) PG8_BAR;
        E(acc, cur, wr, wc, fr, fq);
        if (!has_next) break;
#pragma unroll
        for (int a = 0; a < 2; ++a)
#pragma unroll
            for (int b = 0; b < 2; ++b)
#pragma unroll
                for (int m = 0; m < 4; ++m)
#pragma unroll
                    for (int n = 0; n < 2; ++n) acc[a][b][m][n] = (f32x4){0.f, 0.f, 0.f, 0.f};
        cur = nxt; cA = nA; cB = nB; ++ui;
        if constexpr (GATHER) { gc00 = gn00; gc01 = gn01; gc10 = gn10; gc11 = gn11; }
        if (wr == 1) PG8_BAR;
    }
    PG8_WAIT_V(0);
    PG8_BAR;
#undef PG8_SA
#undef PG8_SB
#undef PG8_GLDS
#undef PG8_STAGE_A
#undef PG8_STAGE_B
#undef PG8_LDA
#undef PG8_LDB
#undef PG8_MMA
#undef PG8_WAIT_V
#undef PG8_WAIT_L
#undef PG8_BAR
#undef PG8_SCHED
#undef PG8_GOFF
}
}
using pg8::Unit;

#define XB_TMO      128
#define XB_XCNT(j)  (256  + 64 * (j))
#define XB_XSUB(j)  (1280 + 64 * (j))
#define XB_XGEN(j)  (2304 + 64 * (j))
#define XB_TOP      3328
#define XB_TOPGEN   3392
#define XCD_BAR_WORDS 3456
#define XB_SPIN_CAP (1u << 20)
__device__ __forceinline__ unsigned xb_ld(unsigned* p)              { return __hip_atomic_load(p, __ATOMIC_RELAXED, __HIP_MEMORY_SCOPE_AGENT); }
__device__ __forceinline__ unsigned xb_add(unsigned* p, unsigned v) { return __hip_atomic_fetch_add(p, v, __ATOMIC_RELAXED, __HIP_MEMORY_SCOPE_AGENT); }
__device__ __forceinline__ unsigned xb_xcc_id() { return (unsigned)__builtin_amdgcn_s_getreg((3 << 11) | 20) & 0xFu; }
#define XB_SPIN(cond, bar) do { unsigned _sp = 0; while (cond) { __builtin_amdgcn_s_sleep(1); \
    if ((++_sp & 255u) == 0u) { if (xb_ld(&(bar)[XB_TMO])) break; if (_sp > XB_SPIN_CAP) { atomicAdd(&(bar)[XB_TMO], 1u); break; } } } } while (0)
struct XcdBarrier { unsigned* bar; unsigned x; volatile LAS unsigned* st; };
__device__ __forceinline__ XcdBarrier xcd_barrier_post(unsigned* bar, volatile LAS unsigned* st) {
    XcdBarrier b; b.bar = bar; b.x = xb_xcc_id(); b.st = st;
    if (threadIdx.x == 0) (void)xb_add(&bar[XB_XCNT(b.x)], 1u);
    return b;
}
__device__ __forceinline__ void xcd_barrier_complete(unsigned* bar, unsigned x, unsigned& nloc, unsigned& nx) {
    const unsigned G = gridDim.x * gridDim.y * gridDim.z;
    unsigned sum, cnt, mine, sp = 0u;
    for (;;) {
        sum = 0u; cnt = 0u; mine = 0u;
#pragma unroll
        for (unsigned j = 0; j < 16; ++j) { const unsigned c = xb_ld(&bar[XB_XCNT(j)]); sum += c; cnt += (c > 0u) ? 1u : 0u; mine = (j == x) ? c : mine; }
        if (sum == G) break;
        __builtin_amdgcn_s_sleep(1);
        if ((++sp & 255u) == 0u) { if (xb_ld(&bar[XB_TMO])) break; if (sp > XB_SPIN_CAP) { atomicAdd(&bar[XB_TMO], 1u); break; } }
    }
    nloc = mine > 0u ? mine : 1u; nx = cnt > 0u ? cnt : 1u;
}
__device__ __forceinline__ void xcd_barrier(const XcdBarrier& b) {
    asm volatile("s_waitcnt vmcnt(0)" ::: "memory");
    __syncthreads();
    if (threadIdx.x == 0) {
        unsigned* bar = b.bar;
        __builtin_amdgcn_s_waitcnt(0);
        unsigned nloc = b.st[0], nx = b.st[1];
        if (nloc == 0u) { xcd_barrier_complete(bar, b.x, nloc, nx); b.st[0] = nloc; b.st[1] = nx; }
        const unsigned old = xb_add(&bar[XB_XSUB(b.x)], 1u);
        const unsigned gen = old / nloc;
        if (old + 1u == (gen + 1u) * nloc) {
            __builtin_amdgcn_fence(__ATOMIC_RELEASE, "agent");
            asm volatile("s_waitcnt vmcnt(0)" ::: "memory");
            const unsigned og = xb_add(&bar[XB_TOP], 1u);
            const unsigned tg = og / nx;
            if (og + 1u == (tg + 1u) * nx) xb_add(&bar[XB_TOPGEN], 1u);
            else XB_SPIN(xb_ld(&bar[XB_TOPGEN]) == tg, bar);
            __builtin_amdgcn_fence(__ATOMIC_ACQUIRE, "agent");
            xb_add(&bar[XB_XGEN(b.x)], 1u);
            asm volatile("s_waitcnt vmcnt(0)" ::: "memory");
        } else {
            XB_SPIN(xb_ld(&bar[XB_XGEN(b.x)]) == gen, bar);
            __builtin_amdgcn_fence(__ATOMIC_ACQUIRE, "agent");
            asm volatile("s_waitcnt vmcnt(0)" ::: "memory");
        }
    }
    __syncthreads();
}

struct Args { const float* in[17]; float* out; unsigned char* ws; int ph_lo, ph_hi, li, pad; };
struct Frame {
    LAS unsigned char* lds; volatile LAS unsigned* MISC; unsigned* ctl;
    int tid, lane, wave, vcu, G; unsigned* cnt;
    const float* in[17]; float* out; unsigned char* ws;
};

__device__ __forceinline__ void p0_transpose_item(const float* W, int ldw, h16* WT, int K, int k0, int n0, int drow0, LAS float* scr, int lane) {
    float tv[32];
#pragma unroll
    for (int i = 0; i < 32; ++i) tv[i] = W[(size_t)(k0 + 2 * i + (lane >> 5)) * ldw + n0 + (lane & 31)];
#pragma unroll
    for (int i = 0; i < 32; ++i) scr[(2 * i + (lane >> 5)) * 33 + (lane & 31)] = tv[i];
    LDS_WAIT(); asm volatile("" ::: "memory");
    const int c = lane & 7;
#pragma unroll
    for (int j = 0; j < 4; ++j) { const int n = (lane >> 3) + 8 * j; const LAS float* s = scr + (8 * c) * 33 + n;
        u32x4 o; o.x = pkh(s[0 * 33], s[1 * 33]); o.y = pkh(s[2 * 33], s[3 * 33]); o.z = pkh(s[4 * 33], s[5 * 33]); o.w = pkh(s[6 * 33], s[7 * 33]);
        *(u32x4*)(WT + (size_t)(drow0 + n) * K + k0 + 8 * c) = o; }
    LDS_WAIT(); asm volatile("" ::: "memory");
}
__device__ __forceinline__ void p0_prologue(Frame& F) {
    LAS float* scr = (LAS float*)(F.lds + F.wave * 16384);
    const int gw = F.vcu * 8 + F.wave, NGW = F.G * 8, lane = F.lane;
    unsigned char* ws = F.ws;
    constexpr int I_IN = 16 * 160, I_SB = 8 * 32, I_CV = 8 * 32, I_OUT = 16 * 32, I_G = 32 * 16 * 8, I_U = I_G, I_D = 32 * 4 * 32;
    constexpr int NITEMS = I_IN + I_SB + I_CV + I_OUT;
    for (int it = gw; it < NITEMS; it += NGW) {
        int r = it;
        if (r < I_IN) { const int kb = r / 160, nb = r % 160, n0 = nb * 32; int drow = n0;
            if (n0 < 1536) { const int tile = n0 >> 8, within = n0 & 255, wc = within >> 6, bj = (within >> 5) & 1; drow = tile * 256 + 128 * bj + 32 * wc; }
            p0_transpose_item(F.in[2], NPROJ, (h16*)(ws + WS_WIN), DM, kb * 64, n0, drow, scr, lane); continue; } r -= I_IN;
        if (r < I_SB) { const int kb = r / 32, nb = r % 32; p0_transpose_item(F.in[6], DM, (h16*)(ws + WS_WSB), AW, kb * 64, nb * 32, nb * 32, scr, lane); continue; } r -= I_SB;
        if (r < I_CV) { const int kb = r / 32, nb = r % 32; p0_transpose_item(F.in[7], DM, (h16*)(ws + WS_WCV), AW, kb * 64, nb * 32, nb * 32, scr, lane); continue; } r -= I_CV;
        { const int kb = r / 32, nb = r % 32; p0_transpose_item(F.in[8], DM, (h16*)(ws + WS_WOUT), DM, kb * 64, nb * 32, nb * 32, scr, lane); }
    }
    { float* RW = (float*)(ws + WS_RW); const float* g2 = F.in[9]; const float* wg = F.in[10]; const float* we = F.in[12];
      for (int i = (F.vcu * 8 + F.wave) * 64 + lane; i < 36 * 1024; i += F.G * 512) { const int c = i >> 10, k = i & 1023; RW[i] = g2[k] * (c < 4 ? wg[k * 4 + c] : we[k * 32 + (c - 4)]); } }
    { const float* g1 = F.in[1]; h16* H = (h16*)(ws + WS_H);
      f32x4 gv[4];
#pragma unroll
      for (int j = 0; j < 4; ++j) gv[j] = ((const f32x4*)g1)[lane + 64 * j];
      for (int m0 = gw; m0 < NTOK; m0 += 4 * NGW) {
        f32x4 v[4][4];
#pragma unroll
        for (int i = 0; i < 4; ++i) { const int m = m0 + i * NGW; const f32x4* xr = (const f32x4*)(F.in[0] + (size_t)(m < NTOK ? m : m0) * DM) + lane;
#pragma unroll
            for (int j = 0; j < 4; ++j) v[i][j] = xr[64 * j]; }
#pragma unroll
        for (int i = 0; i < 4; ++i) { const int m = m0 + i * NGW; if (m < NTOK) { float s = 0.f;
#pragma unroll
            for (int j = 0; j < 4; ++j) s += (v[i][j].x * v[i][j].x + v[i][j].y * v[i][j].y) + (v[i][j].z * v[i][j].z + v[i][j].w * v[i][j].w);
            const float rstd = rsqrtf(wave_total(s) * (1.f / DM) + EPS);
            u32x2* o8 = (u32x2*)(H + (size_t)m * DM) + lane;
#pragma unroll
            for (int j = 0; j < 4; ++j) { const f32x4 y = v[i][j] * rstd * gv[j]; u32x2 w; w.x = pkh(y.x, y.y); w.y = pkh(y.z, y.w); o8[64 * j] = w; } } }
      } }
}

__device__ __forceinline__ void convert_experts(Frame& F) {
    LAS float* scr = (LAS float*)(F.lds + F.wave * 16384);
    const int gw = F.vcu * 8 + F.wave, NGW = F.G * 8, lane = F.lane; unsigned char* ws = F.ws;
    constexpr int I_G = 32 * 16 * 8, I_U = I_G, I_D = 32 * 4 * 32;
    for (int it = gw; it < I_G + I_U + I_D; it += NGW) {
        int r = it;
        if (r < I_G + I_U) { const int up = r >= I_G; if (up) r -= I_G; const int e = r / 128, q = r % 128, kb = q / 8, nb = q % 8, n0 = nb * 32;
            const int drow = 256 * (n0 >> 7) + 128 * up + (n0 & 127);
            p0_transpose_item(F.in[up ? 15 : 14] + (size_t)e * DM * DEXP, DEXP, (h16*)(ws + WS_W1) + (size_t)e * 512 * DM, DM, kb * 64, n0, drow, scr, lane); continue; } r -= I_G + I_U;
        { const int e = r / 128, q = r % 128, kb = q / 32, nb = q % 32;
            p0_transpose_item(F.in[16] + (size_t)e * DEXP * DM, DM, (h16*)(ws + WS_W2) + (size_t)e * DM * DEXP, DEXP, kb * 64, nb * 32, nb * 32, scr, lane); }
    }
}

struct StaticOrder {
    const char* A; const char* Bt; int nM, nN, G, c; size_t tstep;
    __device__ __forceinline__ bool next(int i, Unit& u) const {
        const int L = i * G + c; if (L >= nM * nN) return false;
        int pm, pn; pg8::tile_of(L, nM, nN, pm, pn); u.pm = pm; u.pn = pn; u.e = 0; u.nrows = 256; u.lst = nullptr; u.wl = nullptr;
        u.a = A + (size_t)pm * tstep; u.b = Bt + (size_t)pn * tstep; return true;
    }
    __device__ __forceinline__ int tok(const Unit&, int) const { return 0; }
};
struct BranchOrder {
    const char* Aa; const char* Ab; const char* Ba; const char* Bb; int G, c;
    __device__ __forceinline__ bool next(int i, Unit& u) const {
        const int L = (i >> 1) * G + c; if (L >= 64 * 4) return false;
        int pm, pn; pg8::tile_of(L, 64, 4, pm, pn); u.pm = pm; u.pn = pn; u.e = i & 1; u.nrows = 256; u.lst = nullptr; u.wl = nullptr;
        const size_t tstep = (size_t)256 * AW * 2;
        u.a = ((i & 1) ? Ab : Aa) + (size_t)pm * tstep; u.b = ((i & 1) ? Bb : Ba) + (size_t)pn * tstep; return true;
    }
    __device__ __forceinline__ int tok(const Unit&, int) const { return 0; }
};
template <int NN, bool G1> struct MoeOrder {
    const LAS int* cntl; const char* A; const char* Bt; const int* tok_list; const float* w_list; int G, c;
    __device__ __forceinline__ bool next(int i, Unit& u) const {
        const int L = i * G + c, mtg = L / NN, pn = L % NN;
        int acc = 0, e = -1, mtl = 0, ce = 0;
        for (int j = 0; j < NEXP; ++j) { const int cj = cntl[j], t = (cj + 255) >> 8; if (e < 0 && mtg < acc + t) { e = j; mtl = mtg - acc; ce = cj; } acc += t; }
        if (e < 0) return false;
        e = __builtin_amdgcn_readfirstlane(e); mtl = __builtin_amdgcn_readfirstlane(mtl); ce = __builtin_amdgcn_readfirstlane(ce);
        u.pm = mtg; u.pn = pn; u.e = e; const int nr = ce - mtl * 256; u.nrows = nr < 256 ? nr : 256;
        u.lst = tok_list + (size_t)e * LCAP + mtl * 256; u.wl = w_list + (size_t)e * LCAP + mtl * 256;
        if (G1) { u.a = A; u.b = Bt + ((size_t)e * 512 + pn * 256) * DM * 2; }
        else { u.a = A + (size_t)mtg * 256 * DEXP * 2; u.b = Bt + ((size_t)e * DM + pn * 256) * DEXP * 2; }
        return true;
    }
    __device__ __forceinline__ int tok(const Unit& u, int r) const { return r < u.nrows ? u.lst[r] : 0; }
};

__device__ __forceinline__ u32x4 pack8(const f32x4 a, const f32x4 b) { u32x4 w; w.x = pkh(a[0], a[1]); w.y = pkh(a[2], a[3]); w.z = pkh(b[0], b[1]); w.w = pkh(b[2], b[3]); return w; }
__device__ __forceinline__ void unpack8(const u32x4 w, f32x4& a, f32x4& b) {
    const h16x8 h = __builtin_bit_cast(h16x8, w);
    a = (f32x4){(float)h[0], (float)h[1], (float)h[2], (float)h[3]}; b = (f32x4){(float)h[4], (float)h[5], (float)h[6], (float)h[7]};
}
struct EpiProj {
    static constexpr bool PERM = true;
    unsigned char* ws; const float* qg; const float* kg;
    __device__ __forceinline__ void operator()(const f32x4 (&acc)[2][2][4][2], const Unit& u, int wr, int wc, int fr, int fq) const {
        const int row0 = u.pm * 256 + wr * 64 + fr, pn = u.pn;
        if (pn < 4) {
            const bool isq = pn < 2; const int head = 4 * (pn & 1) + wc; const float* gp = isq ? qg : kg; const float sc = isq ? 0.125f * 1.4426950408889634f : 1.0f;
            h16* dst = (h16*)(ws + (isq ? WS_Q : WS_K));
            const f32x4 g00 = *(const f32x4*)(gp + 8 * fq), g01 = *(const f32x4*)(gp + 8 * fq + 4), g10 = *(const f32x4*)(gp + 32 + 8 * fq), g11 = *(const f32x4*)(gp + 32 + 8 * fq + 4);
#pragma unroll
            for (int ai = 0; ai < 2; ++ai)
#pragma unroll
                for (int m = 0; m < 4; ++m) {
                    const f32x4 a0 = acc[ai][0][m][0], a1 = acc[ai][0][m][1], b0 = acc[ai][1][m][0], b1 = acc[ai][1][m][1];
                    float ss = (a0[0] * a0[0] + a0[1] * a0[1]) + (a0[2] * a0[2] + a0[3] * a0[3]) + (a1[0] * a1[0] + a1[1] * a1[1]) + (a1[2] * a1[2] + a1[3] * a1[3])
                             + (b0[0] * b0[0] + b0[1] * b0[1]) + (b0[2] * b0[2] + b0[3] * b0[3]) + (b1[0] * b1[0] + b1[1] * b1[1]) + (b1[2] * b1[2] + b1[3] * b1[3]);
                    ss += __shfl_xor(ss, 16); ss += __shfl_xor(ss, 32);
                    const float r = rsqrtf(ss * (1.f / HD) + EPS) * sc;
                    h16* rowp = dst + (size_t)(row0 + ai * 128 + m * 16) * AW + head * HD + 8 * fq;
                    __builtin_nontemporal_store(pack8(a0 * r * g00, a1 * r * g01), (u32x4*)(rowp));
                    __builtin_nontemporal_store(pack8(b0 * r * g10, b1 * r * g11), (u32x4*)(rowp + 32));
                }
        } else if (pn < 6) {
            const int head = 4 * (pn & 1) + wc; h16* VT = (h16*)(ws + WS_VT);
            const int pf = fr ^ ((((fr >> 2) ^ (fr >> 3)) & 1) ? 12 : 0);
#pragma unroll
            for (int ai = 0; ai < 2; ++ai)
#pragma unroll
                for (int m = 0; m < 4; ++m) {
                    const int row = row0 + ai * 128 + m * 16, b = row >> 12, s = row & (SEQ - 1);
                    h16* colp = VT + ((size_t)(b * NH + head) * HD + 8 * fq) * SEQ + (s & ~15) + pf;
#pragma unroll
                    for (int bj = 0; bj < 2; ++bj)
#pragma unroll
                        for (int n = 0; n < 2; ++n)
#pragma unroll
                            for (int j = 0; j < 4; ++j) colp[(size_t)(32 * bj + 4 * n + j) * SEQ] = (h16)acc[ai][bj][m][n][j];
                }
        } else {
            const bool gate = pn >= 12; h16* dst; int ldc, col0;
            if (!gate) { const int w = (pn - 6) >> 1; dst = (h16*)(ws + WS_CB + (size_t)w * 16 * MiB); ldc = AW; col0 = ((pn - 6) & 1) * 256; }
            else { const int w = (pn - 12) >> 2; dst = (h16*)(ws + WS_GA + (size_t)w * 32 * MiB); ldc = DM; col0 = ((pn - 12) & 3) * 256; }
            col0 += wc * 32 + 8 * fq;
#pragma unroll
            for (int ai = 0; ai < 2; ++ai)
#pragma unroll
                for (int m = 0; m < 4; ++m) { h16* rowp = dst + (size_t)(row0 + ai * 128 + m * 16) * ldc + col0;
#pragma unroll
                    for (int bj = 0; bj < 2; ++bj) { f32x4 v0 = acc[ai][bj][m][0], v1 = acc[ai][bj][m][1];
                        if (gate) {
#pragma unroll
                            for (int j = 0; j < 4; ++j) { v0[j] = sigmoidf_(v0[j]); v1[j] = sigmoidf_(v1[j]); } }
                        __builtin_nontemporal_store(pack8(v0, v1), (u32x4*)(rowp + bj * 128)); } }
        }
    }
};
struct EpiBranch {
    static constexpr bool PERM = true;
    unsigned char* ws;
    __device__ __forceinline__ void operator()(const f32x4 (&acc)[2][2][4][2], const Unit& u, int wr, int wc, int fr, int fq) const {
        const int row0 = u.pm * 256 + wr * 64 + fr; const int col0 = u.pn * 256 + wc * 32 + 8 * fq; const bool second = u.e != 0;
        const h16* gt = (const h16*)(ws + (second ? WS_GB : WS_GA)); h16* H = (h16*)(ws + WS_MRG);
#pragma unroll
        for (int ai = 0; ai < 2; ++ai)
#pragma unroll
            for (int m = 0; m < 4; ++m) { const size_t off = (size_t)(row0 + ai * 128 + m * 16) * DM + col0;
#pragma unroll
                for (int bj = 0; bj < 2; ++bj) { f32x4 g0, g1; unpack8(*(const u32x4*)(gt + off + bj * 128), g0, g1);
                    f32x4 v0 = acc[ai][bj][m][0] * g0, v1 = acc[ai][bj][m][1] * g1;
                    if (second) { f32x4 p0, p1; unpack8(*(const u32x4*)(H + off + bj * 128), p0, p1); v0 += p0; v1 += p1; }
                    *(u32x4*)(H + off + bj * 128) = pack8(v0, v1); } }
    }
};
struct EpiOut {
    static constexpr bool PERM = false;
    const float* x; float* out;
    __device__ __forceinline__ void operator()(const f32x4 (&acc)[2][2][4][2], const Unit& u, int wr, int wc, int fr, int fq) const {
        const int row0 = u.pm * 256 + wr * 64 + fr, col0 = u.pn * 256 + wc * 32 + 4 * fq;
#pragma unroll
        for (int ai = 0; ai < 2; ++ai)
#pragma unroll
            for (int m = 0; m < 4; ++m) { const size_t off = (size_t)(row0 + ai * 128 + m * 16) * DM + col0;
#pragma unroll
                for (int bj = 0; bj < 2; ++bj)
#pragma unroll
                    for (int n = 0; n < 2; ++n) { const f32x4 xv = *(const f32x4*)(x + off + bj * 128 + n * 16); *(f32x4*)(out + off + bj * 128 + n * 16) = xv + acc[ai][bj][m][n]; } }
    }
};
struct EpiAct {
    static constexpr bool PERM = true;
    h16* act;
    __device__ __forceinline__ void operator()(const f32x4 (&acc)[2][2][4][2], const Unit& u, int wr, int wc, int fr, int fq) const {
        const int r0 = wr * 64 + fr; const int col0 = u.pn * 128 + wc * 32 + 8 * fq;
#pragma unroll
        for (int ai = 0; ai < 2; ++ai)
#pragma unroll
            for (int m = 0; m < 4; ++m) { const int r = r0 + ai * 128 + m * 16; const float w = r < u.nrows ? u.wl[r] : 0.f;
                f32x4 v0, v1;
#pragma unroll
                for (int j = 0; j < 4; ++j) { const float g0 = acc[ai][0][m][0][j], g1 = acc[ai][0][m][1][j];
                    v0[j] = g0 * sigmoidf_(g0) * acc[ai][1][m][0][j] * w; v1[j] = g1 * sigmoidf_(g1) * acc[ai][1][m][1][j] * w; }
                *(u32x4*)(act + (size_t)(u.pm * 256 + r) * DEXP + col0) = pack8(v0, v1); }
    }
};
struct EpiY {
    static constexpr bool PERM = true;
    h16* y;
    __device__ __forceinline__ void operator()(const f32x4 (&acc)[2][2][4][2], const Unit& u, int wr, int wc, int fr, int fq) const {
        const int row0 = u.pm * 256 + wr * 64 + fr, col0 = u.pn * 256 + wc * 32 + 8 * fq;
#pragma unroll
        for (int ai = 0; ai < 2; ++ai)
#pragma unroll
            for (int m = 0; m < 4; ++m) { h16* rowp = y + (size_t)(row0 + ai * 128 + m * 16) * DM + col0;
#pragma unroll
                for (int bj = 0; bj < 2; ++bj) *(u32x4*)(rowp + bj * 128) = pack8(acc[ai][bj][m][0], acc[ai][bj][m][1]); }
    }
};

constexpr float SB_EXIT = 150.1f;
__device__ __forceinline__ void attn_task(int b, int h, int qblk, const h16* Q, const h16* Kb, const h16* VT, h16* AO, int lane) {
    const int r = lane & 31, hh = lane >> 5;
    const size_t tb = (size_t)b * SEQ;
    const h16* qrow = Q + (tb + qblk * 32 + r) * AW + h * HD + 8 * hh;
    h16x8 bq[4];
#pragma unroll
    for (int s = 0; s < 4; ++s) bq[s] = *(const h16x8*)(qrow + 16 * s);
    f32x16 o0 = {}, o1 = {}; float run = 0.f;
    const h16* kbase = Kb + (tb + r) * AW + h * HD + 8 * hh;
    const h16* vbase = VT + ((size_t)(b * NH + h) * HD + r) * SEQ + 8 * hh;
    h16x8 ak[4], av[2][2];
#pragma unroll
    for (int s = 0; s < 4; ++s) ak[s] = *(const h16x8*)(kbase + (size_t)(qblk * 32) * AW + 16 * s);
#pragma unroll
    for (int db = 0; db < 2; ++db)
#pragma unroll
        for (int s2 = 0; s2 < 2; ++s2) av[db][s2] = *(const h16x8*)(vbase + (size_t)(32 * db) * SEQ + qblk * 32 + 16 * s2);
    for (int kt = qblk; kt >= 0; --kt) {
        const int ktn = kt > 0 ? kt - 1 : 0;
        h16x8 akn[4], avn[2][2];
#pragma unroll
        for (int s = 0; s < 4; ++s) akn[s] = *(const h16x8*)(kbase + (size_t)(ktn * 32) * AW + 16 * s);
#pragma unroll
        for (int db = 0; db < 2; ++db)
#pragma unroll
            for (int s2 = 0; s2 < 2; ++s2) avn[db][s2] = *(const h16x8*)(vbase + (size_t)(32 * db) * SEQ + ktn * 32 + 16 * s2);
        f32x16 p = {};
#pragma unroll
        for (int s = 0; s < 4; ++s) p = __builtin_amdgcn_mfma_f32_32x32x16_f16(ak[s], bq[s], p, 0, 0, 0);
        const bool diag = (kt == qblk);
        float sp[16];
#pragma unroll
        for (int i = 0; i < 16; ++i) { const float z = p[i]; float v = fmaxf(z, 0.f) + __builtin_amdgcn_logf(1.0f + __builtin_amdgcn_exp2f(-fabsf(z)));
            if (diag) { const int key = (i & 3) + 8 * (i >> 2) + 4 * hh; v = key < r ? v : 0.f; }
            sp[i] = v; }
        float G[4], Go[4], T[4];
#pragma unroll
        for (int g = 0; g < 4; ++g) { G[g] = (sp[4 * g] + sp[4 * g + 1]) + (sp[4 * g + 2] + sp[4 * g + 3]); Go[g] = __shfl_xor(G[g], 32); T[g] = G[g] + Go[g]; }
        float base[4];
        base[3] = run; base[2] = run + T[3]; base[1] = base[2] + T[2]; base[0] = base[1] + T[1];
        float a[16];
#pragma unroll
        for (int g = 0; g < 4; ++g) { float t = base[g] + (hh == 0 ? Go[g] : 0.f);
#pragma unroll
            for (int w = 3; w >= 0; --w) { const int i = 4 * g + w; float e = __builtin_amdgcn_exp2f(p[i] - sp[i] - t);
                if (diag) { const int key = (i & 3) + 8 * (i >> 2) + 4 * hh; e = key < r ? e : 0.f; }
                a[i] = e; t += sp[i]; } }
        run = base[0] + T[0];
        h16x8 bp0, bp1;
#pragma unroll
        for (int j = 0; j < 8; ++j) { bp0[j] = (h16)a[j]; bp1[j] = (h16)a[8 + j]; }
        o0 = __builtin_amdgcn_mfma_f32_32x32x16_f16(av[0][0], bp0, o0, 0, 0, 0);
        o0 = __builtin_amdgcn_mfma_f32_32x32x16_f16(av[0][1], bp1, o0, 0, 0, 0);
        o1 = __builtin_amdgcn_mfma_f32_32x32x16_f16(av[1][0], bp0, o1, 0, 0, 0);
        o1 = __builtin_amdgcn_mfma_f32_32x32x16_f16(av[1][1], bp1, o1, 0, 0, 0);
        if (__all(run > SB_EXIT)) break;
#pragma unroll
        for (int s = 0; s < 4; ++s) ak[s] = akn[s];
#pragma unroll
        for (int db = 0; db < 2; ++db)
#pragma unroll
            for (int s2 = 0; s2 < 2; ++s2) av[db][s2] = avn[db][s2];
    }
    h16* orow = AO + (tb + qblk * 32 + r) * AW + h * HD + 4 * hh;
#pragma unroll
    for (int g = 0; g < 4; ++g) {
        u32x2 w0; w0.x = pkh(o0[4 * g], o0[4 * g + 1]); w0.y = pkh(o0[4 * g + 2], o0[4 * g + 3]); *(u32x2*)(orow + 8 * g) = w0;
        u32x2 w1; w1.x = pkh(o1[4 * g], o1[4 * g + 1]); w1.y = pkh(o1[4 * g + 2], o1[4 * g + 3]); *(u32x2*)(orow + 32 + 8 * g) = w1; }
}
__device__ __forceinline__ void p2_attn_conv(Frame& F) {
    const int gw = F.vcu * 8 + F.wave, NGW = F.G * 8, lane = F.lane;
    const h16* Q = (const h16*)(F.ws + WS_Q); h16* AO = (h16*)(F.ws + WS_AO); const h16* Kb = (const h16*)(F.ws + WS_K); const h16* VT = (const h16*)(F.ws + WS_VT);
    if (F.wave >= 4) convert_experts(F);
    for (int t = gw; t < 32 * 64; t += NGW) { const int bh = t >> 6, j = t & 63;
        attn_task(bh >> 3, bh & 7, 127 - j, Q, Kb, VT, AO, lane);
        attn_task(bh >> 3, bh & 7, j, Q, Kb, VT, AO, lane); }
    if (F.wave < 4) convert_experts(F);
    const h16* CB = (const h16*)(F.ws + WS_CB); h16* CO = (h16*)(F.ws + WS_CO); const h16* CC = (const h16*)(F.ws + WS_CC); const h16* CU = (const h16*)(F.ws + WS_CU); const float* cw = F.in[5];
    f32x4 w0a = *(const f32x4*)(cw + 8 * lane), w0b = *(const f32x4*)(cw + 8 * lane + 4), w1a = *(const f32x4*)(cw + AW + 8 * lane), w1b = *(const f32x4*)(cw + AW + 8 * lane + 4),
          w2a = *(const f32x4*)(cw + 2 * AW + 8 * lane), w2b = *(const f32x4*)(cw + 2 * AW + 8 * lane + 4);
    for (int c = gw; c < NTOK / 8; c += NGW) { const int t0 = c * 8; const bool first = (t0 & (SEQ - 1)) == 0;
        f32x4 pa2 = {}, pb2 = {}, pa1 = {}, pb1 = {};
        if (!first) { f32x4 x0, x1, y0, y1;
            unpack8(*(const u32x4*)(CC + (size_t)(t0 - 2) * AW + 8 * lane), x0, x1); unpack8(*(const u32x4*)(CU + (size_t)(t0 - 2) * AW + 8 * lane), y0, y1); pa2 = x0 * y0; pb2 = x1 * y1;
            unpack8(*(const u32x4*)(CC + (size_t)(t0 - 1) * AW + 8 * lane), x0, x1); unpack8(*(const u32x4*)(CU + (size_t)(t0 - 1) * AW + 8 * lane), y0, y1); pa1 = x0 * y0; pb1 = x1 * y1; }
#pragma unroll
        for (int i = 0; i < 8; ++i) { const size_t off = (size_t)(t0 + i) * AW + 8 * lane; f32x4 x0, x1, y0, y1, b0, b1;
            unpack8(*(const u32x4*)(CC + off), x0, x1); unpack8(*(const u32x4*)(CU + off), y0, y1); unpack8(*(const u32x4*)(CB + off), b0, b1);
            const f32x4 pa0 = x0 * y0, pb0 = x1 * y1;
            const f32x4 ya = b0 * (w0a * pa2 + w1a * pa1 + w2a * pa0), yb = b1 * (w0b * pb2 + w1b * pb1 + w2b * pb0);
            *(u32x4*)(CO + off) = pack8(ya, yb);
            pa2 = pa1; pb2 = pb1; pa1 = pa0; pb1 = pb0; } }
}

__device__ __forceinline__ void p5_router(Frame& F) {
    const int gw = F.vcu * 8 + F.wave, NGW = F.G * 8, lane = F.lane;
    LAS float* RW = (LAS float*)F.lds;
    { const f32x4* src = (const f32x4*)(F.ws + WS_RW); LAS f32x4* dst = (LAS f32x4*)F.lds;
      for (int i = F.tid; i < 36 * 1024 / 4; i += 512) dst[i] = src[i]; }
    LAS unsigned* lcnt = (LAS unsigned*)(F.MISC + 128); LAS unsigned* lbase = (LAS unsigned*)(F.MISC + 160);
    const float* g2 = F.in[9]; const float* bg = F.in[11]; const float* be = F.in[13];
    h16* H = (h16*)(F.ws + WS_H); int* TOK = (int*)(F.ws + WS_TOK); float* WL = (float*)(F.ws + WS_WL); i32x4* ROUTE = (i32x4*)(F.ws + WS_ROUTE);
    f32x4 gv[4];
#pragma unroll
    for (int j = 0; j < 4; ++j) gv[j] = ((const f32x4*)g2)[lane + 64 * j];
    for (int base = 0; base < NTOK; base += NGW * 8) {
        if (F.tid < NEXP) lcnt[F.tid] = 0u;
        __syncthreads();
        int ke0 = 0, ke1 = 0, km = -1; float kw0 = 0.f, kw1 = 0.f;
        f32x4 v[4];
        { const int m0 = base + gw; if (m0 < NTOK) { const f32x4* xr = (const f32x4*)(F.out + (size_t)m0 * DM) + lane;
#pragma unroll
            for (int j = 0; j < 4; ++j) v[j] = xr[64 * j]; } }
#pragma unroll 1
        for (int i = 0; i < 8; ++i) {
            const int m = base + gw + i * NGW; if (m >= NTOK) break;
            f32x4 vn[4];
            { const int mn = m + NGW; const bool pf = (i < 7) && (mn < NTOK); const f32x4* xr = (const f32x4*)(F.out + (size_t)(pf ? mn : m) * DM) + lane;
#pragma unroll
              for (int j = 0; j < 4; ++j) vn[j] = xr[64 * j]; }
            float s = 0.f;
#pragma unroll
            for (int j = 0; j < 4; ++j) s += (v[j].x * v[j].x + v[j].y * v[j].y) + (v[j].z * v[j].z + v[j].w * v[j].w);
            const float rstd = rsqrtf(wave_total(s) * (1.f / DM) + EPS);
            u32x2* o8 = (u32x2*)(H + (size_t)m * DM) + lane;
#pragma unroll
            for (int j = 0; j < 4; ++j) { const f32x4 y = v[j] * rstd * gv[j]; u32x2 w; w.x = pkh(y.x, y.y); w.y = pkh(y.z, y.w); o8[64 * j] = w; }
            float lg[4];
#pragma unroll
            for (int c = 0; c < 4; ++c) { float a = 0.f;
#pragma unroll
                for (int j = 0; j < 4; ++j) { const f32x4 w = *(const LAS f32x4*)(RW + c * 1024 + 256 * j + 4 * lane); a += (v[j].x * w.x + v[j].y * w.y) + (v[j].z * w.z + v[j].w * w.w); }
                lg[c] = wave_total(a) * rstd + bg[c]; }
            int gi = 0; float gm = lg[0];
#pragma unroll
            for (int c = 1; c < 4; ++c) if (lg[c] > gm) { gm = lg[c]; gi = c; }
            gi = __builtin_amdgcn_readfirstlane(gi);
            float den = 0.f;
#pragma unroll
            for (int c = 0; c < 4; ++c) den += __expf(lg[c] - gm);
            const float gwt = 1.0f / den;
            float ev[8];
            { const LAS float* rw = RW + (4 + 8 * gi) * 1024 + 4 * lane; const float* bp = be + 8 * gi;
#pragma unroll
              for (int c = 0; c < 8; ++c) { float a = 0.f;
#pragma unroll
                for (int j = 0; j < 4; ++j) { const f32x4 w = *(const LAS f32x4*)(rw + c * 1024 + 256 * j); a += (v[j].x * w.x + v[j].y * w.y) + (v[j].z * w.z + v[j].w * w.w); }
                ev[c] = wave_total(a) * rstd + bp[c]; } }
            int i0 = 0; float v0 = ev[0];
#pragma unroll
            for (int c = 1; c < 8; ++c) if (ev[c] > v0) { v0 = ev[c]; i0 = c; }
            int i1 = -1; float v1 = -INFINITY;
#pragma unroll
            for (int c = 0; c < 8; ++c) if (c != i0 && ev[c] > v1) { v1 = ev[c]; i1 = c; }
            const float e1 = __expf(v1 - v0), w0 = gwt / (1.0f + e1), w1 = gwt * e1 / (1.0f + e1);
            if (lane == i) { ke0 = gi * 8 + i0; ke1 = gi * 8 + i1; kw0 = w0; kw1 = w1; km = m; }
#pragma unroll
            for (int j = 0; j < 4; ++j) v[j] = vn[j];
        }
        unsigned p0 = 0, p1 = 0;
        if (km >= 0) { p0 = __hip_atomic_fetch_add(lcnt + ke0, 1u, __ATOMIC_RELAXED, __HIP_MEMORY_SCOPE_WORKGROUP); p1 = __hip_atomic_fetch_add(lcnt + ke1, 1u, __ATOMIC_RELAXED, __HIP_MEMORY_SCOPE_WORKGROUP); }
        __syncthreads();
        if (F.tid < NEXP) { const unsigned c = lcnt[F.tid]; lbase[F.tid] = c ? atomicAdd(F.cnt + 64 * F.tid, c) : 0u; }
        __syncthreads();
        if (km >= 0) { const int q0 = (int)(lbase[ke0] + p0), q1 = (int)(lbase[ke1] + p1);
            TOK[(size_t)ke0 * LCAP + q0] = km; WL[(size_t)ke0 * LCAP + q0] = kw0; TOK[(size_t)ke1 * LCAP + q1] = km; WL[(size_t)ke1 * LCAP + q1] = kw1;
            ROUTE[km] = (i32x4){ke0, q0, ke1, q1}; }
        __syncthreads();
    }
}
__device__ __forceinline__ void load_counts(Frame& F) {
    __syncthreads();
    if (F.tid < NEXP) F.MISC[64 + F.tid] = __hip_atomic_load(F.cnt + 64 * F.tid, __ATOMIC_RELAXED, __HIP_MEMORY_SCOPE_AGENT);
    __syncthreads();
}
__device__ __forceinline__ void p8_combine(Frame& F) {
    const int gw = F.vcu * 8 + F.wave, NGW = F.G * 8, lane = F.lane;
    const LAS int* cntl = (const LAS int*)(F.MISC + 64); LAS int* pbase = (LAS int*)(F.MISC + 96);
    if (F.tid < NEXP) { int acc = 0; for (int j = 0; j < F.tid; ++j) acc += ((cntl[j] + 255) >> 8) << 8; pbase[F.tid] = acc; }
    __syncthreads();
    const h16* Y = (const h16*)(F.ws + WS_Y); const i32x4* ROUTE = (const i32x4*)(F.ws + WS_ROUTE);
    for (int base = 0; base < NTOK; base += NGW * 8) {
        int r0 = 0, r1 = 0;
        { const int m = base + gw + (lane & 7) * NGW; if (m < NTOK) { const i32x4 rt = ROUTE[m]; r0 = pbase[rt.x] + rt.y; r1 = pbase[rt.z] + rt.w; } }
#pragma unroll
        for (int i4 = 0; i4 < 8; i4 += 4) {
            f32x4 xv[4][4]; u32x2 ya[4][4], yb[4][4];
#pragma unroll
            for (int i = 0; i < 4; ++i) { const int m = base + gw + (i4 + i) * NGW; const int mm = m < NTOK ? m : 0;
                const size_t q0 = (size_t)__builtin_amdgcn_readlane(r0, i4 + i), q1 = (size_t)__builtin_amdgcn_readlane(r1, i4 + i);
                const f32x4* xr = (const f32x4*)(F.out + (size_t)mm * DM) + lane; const u32x2* y0 = (const u32x2*)(Y + q0 * DM) + lane; const u32x2* y1 = (const u32x2*)(Y + q1 * DM) + lane;
#pragma unroll
                for (int j = 0; j < 4; ++j) { xv[i][j] = xr[64 * j]; ya[i][j] = y0[64 * j]; yb[i][j] = y1[64 * j]; } }
#pragma unroll
            for (int i = 0; i < 4; ++i) { const int m = base + gw + (i4 + i) * NGW; if (m < NTOK) { f32x4* xr = (f32x4*)(F.out + (size_t)m * DM) + lane;
#pragma unroll
                for (int j = 0; j < 4; ++j) { f32x4 v = xv[i][j]; const h16x4 a = __builtin_bit_cast(h16x4, ya[i][j]), b = __builtin_bit_cast(h16x4, yb[i][j]);
                    v.x += (float)a[0] + (float)b[0]; v.y += (float)a[1] + (float)b[1]; v.z += (float)a[2] + (float)b[2]; v.w += (float)a[3] + (float)b[3]; xr[64 * j] = v; } } }
        }
    }
}

__global__ void __launch_bounds__(512, 2) hsb_fwd(Args args) {
    extern __shared__ __attribute__((aligned(16))) unsigned char lds[];
    Frame F;
    F.lds = (LAS unsigned char*)lds; F.MISC = (volatile LAS unsigned*)(F.lds + MISC_OFF);
    F.tid = threadIdx.x; F.lane = F.tid & 63; F.wave = __builtin_amdgcn_readfirstlane(F.tid >> 6);
    F.G = gridDim.x; { const int bx = blockIdx.x; F.vcu = (F.G % 8 == 0) ? (bx % 8) * (F.G / 8) + bx / 8 : bx; }
#pragma unroll
    for (int i = 0; i < 17; ++i) F.in[i] = args.in[i];
    F.out = args.out; F.ws = args.ws; F.ctl = (unsigned*)(args.ws + WS_CTL); F.cnt = F.ctl + CW_CNT + args.li * 64 * NEXP;
    for (int u = F.tid; u < 256; u += 512) ((LAS unsigned*)(F.lds + MISC_OFF))[u] = 0u;
    __syncthreads();
    XcdBarrier bar = xcd_barrier_post(F.ctl + CW_BAR + args.li * XCD_BAR_WORDS, F.MISC + 8);
    const int lo = args.ph_lo, hi = args.ph_hi;
#ifndef PH_MASK
#define PH_MASK 0x1ff
#endif
#define IN(k) (((PH_MASK >> (k)) & 1) && lo <= (k) && (k) < hi)
#define SEAM(k) do { if (IN(k) && IN((k) + 1)) xcd_barrier(bar); } while (0)
    unsigned char* ws = args.ws;

#if defined(TS_SEL)
    unsigned long long ts0 = 0, ts1 = 0;
#define STAMP(k) do { if ((k) == TS_SEL) ts0 = __builtin_amdgcn_s_memrealtime(); if ((k) == TS_SEL + 1) ts1 = __builtin_amdgcn_s_memrealtime(); } while (0)
#else
#define STAMP(k) do { } while (0)
#endif
    STAMP(0);
    if (IN(0)) { p0_prologue(F); } SEAM(0); STAMP(1);
    if (IN(1)) {
        StaticOrder S{(const char*)(ws + WS_H), (const char*)(ws + WS_WIN), NTOK / 256, NPROJ / 256, F.G, (int)blockIdx.x, (size_t)256 * DM * 2};
        EpiProj E{ws, F.in[3], F.in[4]};
        pg8::gemm_phase<EpiProj, StaticOrder, false>(F.lds, DM, S, E);
    } SEAM(1); STAMP(2);
    if (IN(2)) { p2_attn_conv(F); } SEAM(2); STAMP(3);
    if (IN(3)) {
        BranchOrder S{(const char*)(ws + WS_AO), (const char*)(ws + WS_CO), (const char*)(ws + WS_WSB), (const char*)(ws + WS_WCV), F.G, (int)blockIdx.x};
        EpiBranch E{ws};
        pg8::gemm_phase<EpiBranch, BranchOrder, false>(F.lds, AW, S, E);
    } SEAM(3); STAMP(4);
    if (IN(4)) {
        StaticOrder S{(const char*)(ws + WS_MRG), (const char*)(ws + WS_WOUT), NTOK / 256, DM / 256, F.G, (int)blockIdx.x, (size_t)256 * DM * 2};
        EpiOut E{F.in[0], F.out};
        pg8::gemm_phase<EpiOut, StaticOrder, false>(F.lds, DM, S, E);
    } SEAM(4); STAMP(5);
    if (IN(5)) { p5_router(F); } SEAM(5); STAMP(6);
    if (IN(6)) {
        load_counts(F);
        MoeOrder<2, true> S{(const LAS int*)(F.MISC + 64), (const char*)(ws + WS_H), (const char*)(ws + WS_W1), (const int*)(ws + WS_TOK), (const float*)(ws + WS_WL), F.G, (int)blockIdx.x};
        EpiAct E{(h16*)(ws + WS_ACT)};
        pg8::gemm_phase<EpiAct, MoeOrder<2, true>, true>(F.lds, DM, S, E);
    } SEAM(6); STAMP(7);
    if (IN(7)) {
        load_counts(F);
        MoeOrder<4, false> S{(const LAS int*)(F.MISC + 64), (const char*)(ws + WS_ACT), (const char*)(ws + WS_W2), (const int*)(ws + WS_TOK), (const float*)(ws + WS_WL), F.G, (int)blockIdx.x};
        EpiY E{(h16*)(ws + WS_Y)};
        pg8::gemm_phase<EpiY, MoeOrder<4, false>, false>(F.lds, DEXP, S, E);
    } SEAM(7); STAMP(8);
    if (IN(8)) { load_counts(F); p8_combine(F); }
#if defined(TS_SEL)
    xcd_barrier(bar); STAMP(9);
    if (blockIdx.x == 0 && F.tid == 0) F.out[0] = (float)(ts1 - ts0) * 0.01f - (float)(TS_OFF);
#endif
#undef IN
#undef SEAM
}

extern "C" void kernel_launch(void* const* d_in, const int* in_sizes, int n_in, void* d_out, int out_size, void* d_ws, size_t ws_size, hipStream_t stream) {
    static int grid = 0;
    if (grid == 0) {
        if (n_in != 17 || in_sizes[0] != NTOK * DM || out_size != NTOK * DM || ws_size < WS_END) {
            fprintf(stderr, "kernel_launch: unexpected problem: n_in %d in0 %d out %d ws %zu; nothing launched\n", n_in, n_in > 0 ? in_sizes[0] : -1, out_size, ws_size); grid = -1; return; }
        int dev = 0, cus = 0, per_cu = 0;
        if (hipGetDevice(&dev) != hipSuccess || hipDeviceGetAttribute(&cus, hipDeviceAttributeMultiprocessorCount, dev) != hipSuccess) { fprintf(stderr, "kernel_launch: device query failed\n"); grid = -1; return; }
        if (hipFuncSetAttribute((const void*)hsb_fwd, hipFuncAttributeMaxDynamicSharedMemorySize, LDS_BYTES) != hipSuccess) { fprintf(stderr, "kernel_launch: hipFuncSetAttribute failed\n"); grid = -1; return; }
        if (hipOccupancyMaxActiveBlocksPerMultiprocessor(&per_cu, (const void*)hsb_fwd, 512, LDS_BYTES) != hipSuccess || per_cu < 1) {
            fprintf(stderr, "kernel_launch: occupancy query reports %d workgroups per CU\n", per_cu); (void)hipGetLastError(); per_cu = 1; }
        grid = cus;
    }
    if (grid < 0) return;
    (void)hipMemsetAsync((char*)d_ws + WS_CTL, 0, CTL_BYTES, stream);
    Args a{};
    for (int i = 0; i < 17; ++i) a.in[i] = (const float*)d_in[i];
    a.out = (float*)d_out; a.ws = (unsigned char*)d_ws;
#if defined(PROBE_DUP_LO)
    const int plan[2][2] = {{0, PROBE_DUP_HI}, {PROBE_DUP_LO, N_PHASES}}; const int nl = 2;
#elif MK_N_LAUNCHES == 1
    const int plan[1][2] = {{0, N_PHASES}}; const int nl = 1;
#else
    int plan[N_PHASES][2]; for (int p = 0; p < N_PHASES; ++p) { plan[p][0] = p; plan[p][1] = p + 1; } const int nl = N_PHASES;
#endif
    for (int l = 0; l < nl; ++l) { a.ph_lo = plan[l][0]; a.ph_hi = plan[l][1]; a.li = l; hipLaunchKernelGGL(hsb_fwd, dim3(grid), dim3(512), LDS_BYTES, stream, a); }
}
```

```cpp
#include <hip/hip_runtime.h>
#include <cstdio>
#include <cstdint>

#define LAS __attribute__((address_space(3)))
#define GAS __attribute__((address_space(1)))
typedef _Float16 h16;
typedef h16 h16x8 __attribute__((ext_vector_type(8)));
typedef h16 h16x4 __attribute__((ext_vector_type(4)));
typedef h16 h16x2 __attribute__((ext_vector_type(2)));
typedef float f32x2 __attribute__((ext_vector_type(2)));
typedef float f32x4 __attribute__((ext_vector_type(4)));
typedef float f32x16 __attribute__((ext_vector_type(16)));
typedef unsigned u32x2 __attribute__((ext_vector_type(2)));
typedef unsigned u32x4 __attribute__((ext_vector_type(4)));
typedef int i32x4 __attribute__((ext_vector_type(4)));

#ifndef MK_N_LAUNCHES
#define MK_N_LAUNCHES 1
#endif
constexpr int N_PHASES = 9;

constexpr int NTOK = 16384, SEQ = 4096, DM = 1024, NH = 8, HD = 64, AW = 512, NPROJ = 5120, NEXP = 32, DEXP = 256;
constexpr float EPS = 1e-6f;
constexpr int LCAP = 16384;
constexpr size_t MiB = 1u << 20;
constexpr size_t WS_CTL = 0, CTL_BYTES = 256 * 1024;
constexpr size_t WS_RW = 512 * 1024;
constexpr size_t WS_WIN = 1 * MiB, WS_WSB = 11 * MiB, WS_WCV = 12 * MiB, WS_WOUT = 13 * MiB, WS_W1 = 15 * MiB, WS_W2 = 47 * MiB;
constexpr size_t WS_H = 63 * MiB;
constexpr size_t WS_Q = 95 * MiB, WS_K = 111 * MiB, WS_VT = 127 * MiB, WS_CB = 143 * MiB, WS_CC = 159 * MiB, WS_CU = 175 * MiB, WS_GA = 191 * MiB, WS_GB = 223 * MiB;
constexpr size_t WS_AO = WS_H, WS_CO = WS_H + 16 * MiB;
constexpr size_t WS_MRG = WS_Q;
constexpr size_t WS_ACT = WS_Q;
constexpr size_t WS_Y = WS_VT;
constexpr size_t WS_TOK = WS_GB, WS_WL = WS_GB + 2 * MiB, WS_ROUTE = WS_GB + 4 * MiB;
constexpr size_t WS_END = 256 * MiB;
constexpr int CW_CNT = 64;
constexpr int CW_BAR = 8192;

constexpr int RING_BYTES = 131072;
constexpr int SCR_BYTES = 147456;
constexpr int MISC_OFF = SCR_BYTES;
constexpr int LDS_BYTES = SCR_BYTES + 1024;

#define LDS_WAIT() asm volatile("s_waitcnt lgkmcnt(0)" ::: "memory")
#define VM_WAIT() asm volatile("s_waitcnt vmcnt(0)" ::: "memory")

__device__ __forceinline__ unsigned pkh(float lo, float hi) { f32x2 v = {lo, hi}; h16x2 b = __builtin_convertvector(v, h16x2); return __builtin_bit_cast(unsigned, b); }
__device__ __forceinline__ float wave_sum(float v) {
#pragma unroll
    for (int o = 1; o < 64; o <<= 1) v += __shfl_xor(v, o);
    return v;
}
template <int CTRL, int ROWMASK> __device__ __forceinline__ float dpp_mov(float v) { return __builtin_bit_cast(float, __builtin_amdgcn_update_dpp(0, __builtin_bit_cast(int, v), CTRL, ROWMASK, 0xf, false)); }
__device__ __forceinline__ float row_sum16(float v) {
    v += dpp_mov<0xB1, 0xf>(v); v += dpp_mov<0x4E, 0xf>(v); v += dpp_mov<0x141, 0xf>(v); v += dpp_mov<0x140, 0xf>(v); return v;
}
__device__ __forceinline__ float wave_total(float v) {
    v = row_sum16(v);
    v += dpp_mov<0x142, 0xa>(v);
    v += dpp_mov<0x143, 0xc>(v);
    return __builtin_bit_cast(float, __builtin_amdgcn_readlane(__builtin_bit_cast(int, v), 63));
}
__device__ __forceinline__ float sigmoidf_(float x) { return __builtin_amdgcn_rcpf(1.0f + __expf(-x)); }

namespace pg8 {
constexpr int BM = 256, BK = 64, HALF = 128, HTB = HALF * BK * 2, NXCD = 8, WGM = 8;
__device__ __forceinline__ int lds_byte(int r, int c) { const int st = (r >> 4) * 2 + (c >> 5), rr = r & 15, cc = c & 31, ob = rr * 64 + cc * 2; return st * 1024 + (ob ^ (((ob >> 9) & 1) << 5)); }
__device__ __forceinline__ void stage_rc(int b, int& R, int& C) { const int st = b / 1024, sb = b % 1024, swz = sb ^ (((sb >> 9) & 1) << 5); R = (st >> 1) * 16 + swz / 64; C = (st & 1) * 32 + (swz % 64) / 2; }
__device__ __forceinline__ int perm32(int rho) { const int n = rho >> 4, i = rho & 15; return 8 * (i >> 2) + 4 * n + (i & 3); }

struct Unit { const char* a; const char* b; const int* lst; const float* wl; int pm, pn, e, nrows; };

__device__ __forceinline__ void tile_of(int L, int nM, int nN, int& pm, int& pn) {
    const int nwg = nM * nN; int wgid = L; { const int q = nwg / NXCD, r = nwg % NXCD, xcd = wgid % NXCD, off = wgid / NXCD; wgid = (xcd < r ? xcd * (q + 1) : r * (q + 1) + (xcd - r) * q) + off; }
    const int nig = WGM * nN, gid = wgid / nig, fm = gid * WGM, gsz = (nM - fm) < WGM ? (nM - fm) : WGM;
    pm = fm + ((wgid % nig) % gsz); pn = (wgid % nig) / gsz;
}

#if defined(TS_SEL)
#ifndef TS_PH
#define TS_PH -1
#endif
#define GSTAMP(k) do { if (PH == TS_PH) { if ((k) == TS_SEL) tsp[0] = __builtin_amdgcn_s_memrealtime(); if ((k) == TS_END) tsp[1] = __builtin_amdgcn_s_memrealtime(); } } while (0)
#else
#define GSTAMP(k) do { } while (0)
#endif
template <class Epi, class Sched, bool GATHER, int PH = 0>
__device__ __forceinline__ void gemm_phase(LAS unsigned char* lds, const int K, const Sched& S, const Epi& E, unsigned long long* tsp = nullptr) {
    GSTAMP(40);
    const int tid = threadIdx.x, wid = __builtin_amdgcn_readfirstlane(tid >> 6), lane = tid & 63, wr = wid >> 2, wc = wid & 3, fr = lane & 15, fq = lane >> 4;
    const int nt = K / BK;
    unsigned voffA[2], voffB[2]; int RA[2], CA[2];
#pragma unroll
    for (int i = 0; i < 2; ++i) { int R, C; stage_rc(tid * 16 + i * 8192, R, C); const int Rb = Epi::PERM ? ((R & ~31) + perm32(R & 31)) : R;
        RA[i] = R; CA[i] = C; voffA[i] = (unsigned)(R * K + C) * 2u; voffB[i] = (unsigned)(Rb * K + C) * 2u; }
    const size_t kstep = (size_t)(BK * 2);
    const size_t hstep = (size_t)HALF * K * 2;
    const unsigned ldsw = (unsigned)wid * 1024u;
    const int aoff = lds_byte(wr * 64 + fr, fq * 8), boff = lds_byte(wc * 32 + fr, fq * 8);
#define PG8_SA(b, h) (((b) * 2 + (h)) * HTB)
#define PG8_SB(b, h) ((4 + (b) * 2 + (h)) * HTB)
#define PG8_GLDS(bufoff, gptr, i) __builtin_amdgcn_global_load_lds((const unsigned*)(gptr), (LAS unsigned*)(lds + (bufoff) + ldsw + (i) * 8192), 16, 0, 0)
#define PG8_STAGE_B(bufoff, gbase, h) do { PG8_GLDS(bufoff, (const char*)(gbase) + (h) * hstep + voffB[0], 0); PG8_GLDS(bufoff, (const char*)(gbase) + (h) * hstep + voffB[1], 1); } while (0)
#define PG8_STAGE_A(bufoff, gbase, h, v0, v1) do { if constexpr (GATHER) { PG8_GLDS(bufoff, (const char*)(gbase) + (v0), 0); PG8_GLDS(bufoff, (const char*)(gbase) + (v1), 1); } \
        else { PG8_GLDS(bufoff, (const char*)(gbase) + (h) * hstep + voffA[0], 0); PG8_GLDS(bufoff, (const char*)(gbase) + (h) * hstep + voffA[1], 1); } } while (0)
#define PG8_LDA(dst, b, h) do { _Pragma("unroll") for (int m = 0; m < 4; ++m) _Pragma("unroll") for (int k = 0; k < 2; ++k) dst[m][k] = *(const LAS h16x8*)(lds + PG8_SA(b, h) + aoff + m * 2048 + k * 1024); } while (0)
#define PG8_LDB(dst, b, h) do { _Pragma("unroll") for (int n = 0; n < 2; ++n) _Pragma("unroll") for (int k = 0; k < 2; ++k) dst[n][k] = *(const LAS h16x8*)(lds + PG8_SB(b, h) + boff + n * 2048 + k * 1024); } while (0)
#define PG8_MMA(ai, bj, At, Bt) do { __builtin_amdgcn_s_setprio(1); _Pragma("unroll") for (int m = 0; m < 4; ++m) _Pragma("unroll") for (int n = 0; n < 2; ++n) _Pragma("unroll") for (int k = 0; k < 2; ++k) \
        acc[ai][bj][m][n] = __builtin_amdgcn_mfma_f32_16x16x32_f16(Bt[n][k], At[m][k], acc[ai][bj][m][n], 0, 0, 0); __builtin_amdgcn_s_setprio(0); } while (0)
#define PG8_WAIT_V(n) asm volatile("s_waitcnt vmcnt(" #n ")" ::: "memory")
#define PG8_WAIT_L(n) asm volatile("s_waitcnt lgkmcnt(" #n ")" ::: "memory")
#define PG8_BAR __builtin_amdgcn_s_barrier()
#define PG8_SCHED __builtin_amdgcn_sched_barrier(0)
    Unit cur, nxt; int ui = 0;
    if (!S.next(0, cur)) return;
    f32x4 acc[2][2][4][2];
#pragma unroll
    for (int a = 0; a < 2; ++a)
#pragma unroll
        for (int b = 0; b < 2; ++b)
#pragma unroll
            for (int m = 0; m < 4; ++m)
#pragma unroll
                for (int n = 0; n < 2; ++n) acc[a][b][m][n] = (f32x4){0.f, 0.f, 0.f, 0.f};
    h16x8 At[4][2], B0[2][2], B1[2][2];
    const char* cA = cur.a; const char* cB = cur.b;
    unsigned gc00 = 0, gc01 = 0, gc10 = 0, gc11 = 0, gn00 = 0, gn01 = 0, gn10 = 0, gn11 = 0;
#define PG8_GOFF(u, h, i) ((unsigned)(S.tok(u, (h) * HALF + RA[i]) * K + CA[i]) * 2u)
    if constexpr (GATHER) { gc00 = PG8_GOFF(cur, 0, 0); gc01 = PG8_GOFF(cur, 0, 1); gc10 = PG8_GOFF(cur, 1, 0); gc11 = PG8_GOFF(cur, 1, 1); }
    PG8_STAGE_B(PG8_SB(0, 0), cB, 0); PG8_STAGE_B(PG8_SB(0, 1), cB, 1); PG8_STAGE_A(PG8_SA(0, 0), cA, 0, gc00, gc01); PG8_STAGE_A(PG8_SA(0, 1), cA, 1, gc10, gc11);
    if (wr == 1) PG8_BAR;
    PG8_WAIT_V(2); PG8_BAR;
    PG8_STAGE_B(PG8_SB(1, 0), cB + kstep, 0); PG8_STAGE_A(PG8_SA(1, 0), cA + kstep, 0, gc00, gc01); PG8_STAGE_B(PG8_SB(1, 1), cB + kstep, 1);
    PG8_WAIT_V(6); PG8_BAR;
    GSTAMP(41);
    for (;;) {
        const bool has_next = S.next(ui + 1, nxt);
        const char* nA = has_next ? nxt.a : cA; const char* nB = has_next ? nxt.b : cB;
        if constexpr (GATHER) { if (has_next) { gn00 = PG8_GOFF(nxt, 0, 0); gn01 = PG8_GOFF(nxt, 0, 1); gn10 = PG8_GOFF(nxt, 1, 0); gn11 = PG8_GOFF(nxt, 1, 1); } else { gn00 = gc00; gn01 = gc01; gn10 = gc10; gn11 = gc11; } }
#pragma unroll 1
        for (int t = 0; t < nt; t += 2) {
            const bool last = (t == nt - 2);
            const char* a1 = cA + (size_t)(t + 1) * kstep;
            const char* a2 = last ? nA : cA + (size_t)(t + 2) * kstep; const char* b2 = last ? nB : cB + (size_t)(t + 2) * kstep;
            const char* a3 = a2 + kstep; const char* b3 = b2 + kstep;
            unsigned s00 = gc00, s01 = gc01, s10 = gc10, s11 = gc11;
            if constexpr (GATHER) { if (last) { s00 = gn00; s01 = gn01; s10 = gn10; s11 = gn11; } }
            PG8_LDB(B0, 0, 0); PG8_LDB(B1, 0, 1); PG8_SCHED; PG8_LDA(At, 0, 0); PG8_STAGE_A(PG8_SA(1, 1), a1, 1, gc10, gc11);
            PG8_WAIT_V(8); PG8_WAIT_L(0); PG8_BAR; PG8_MMA(0, 0, At, B0); PG8_MMA(0, 1, At, B1); PG8_BAR; PG8_SCHED;
            PG8_LDA(At, 0, 1); PG8_STAGE_B(PG8_SB(0, 0), b2, 0); PG8_STAGE_B(PG8_SB(0, 1), b2, 1); PG8_STAGE_A(PG8_SA(0, 0), a2, 0, s00, s01);
            PG8_WAIT_V(8); PG8_WAIT_L(0); PG8_BAR; PG8_MMA(1, 0, At, B0); PG8_MMA(1, 1, At, B1); PG8_BAR; PG8_SCHED;
            PG8_LDB(B0, 1, 0); PG8_LDB(B1, 1, 1); PG8_SCHED; PG8_LDA(At, 1, 0); PG8_STAGE_A(PG8_SA(0, 1), a2, 1, s10, s11);
            PG8_WAIT_V(8); PG8_WAIT_L(0); PG8_BAR; PG8_MMA(0, 0, At, B0); PG8_MMA(0, 1, At, B1); PG8_BAR; PG8_SCHED;
            PG8_LDA(At, 1, 1); PG8_STAGE_B(PG8_SB(1, 0), b3, 0); PG8_STAGE_B(PG8_SB(1, 1), b3, 1); PG8_STAGE_A(PG8_SA(1, 0), a3, 0, s00, s01);
            PG8_WAIT_V(8); PG8_WAIT_L(0); PG8_BAR; PG8_MMA(1, 0, At, B0); PG8_MMA(1, 1, At, B1); PG8_BAR; PG8_SCHED;
        }
        if (wr == 0) PG8_BAR;
        GSTAMP(42);
        E(acc, cur, wr, wc, fr, fq);
        GSTAMP(43);
        if (!has_next) break;
#pragma unroll
        for (int a = 0; a < 2; ++a)
#pragma unroll
            for (int b = 0; b < 2; ++b)
#pragma unroll
                for (int m = 0; m < 4; ++m)
#pragma unroll
                    for (int n = 0; n < 2; ++n) acc[a][b][m][n] = (f32x4){0.f, 0.f, 0.f, 0.f};
        cur = nxt; cA = nA; cB = nB; ++ui;
        if constexpr (GATHER) { gc00 = gn00; gc01 = gn01; gc10 = gn10; gc11 = gn11; }
        if (wr == 1) PG8_BAR;
    }
    PG8_WAIT_V(0);
    PG8_BAR;
    GSTAMP(44);
#undef PG8_SA
#undef PG8_SB
#undef PG8_GLDS
#undef PG8_STAGE_A
#undef PG8_STAGE_B
#undef PG8_LDA
#undef PG8_LDB
#undef PG8_MMA
#undef PG8_WAIT_V
#undef PG8_WAIT_L
#undef PG8_BAR
#undef PG8_SCHED
#undef PG8_GOFF
}
}
using pg8::Unit;

#define XB_TMO      128
#define XB_XCNT(j)  (256  + 64 * (j))
#define XB_XSUB(j)  (1280 + 64 * (j))
#define XB_XGEN(j)  (2304 + 64 * (j))
#define XB_TOP      3328
#define XB_TOPGEN   3392
#define XCD_BAR_WORDS 3456
#define XB_SPIN_CAP (1u << 20)
__device__ __forceinline__ unsigned xb_ld(unsigned* p)              { return __hip_atomic_load(p, __ATOMIC_RELAXED, __HIP_MEMORY_SCOPE_AGENT); }
__device__ __forceinline__ unsigned xb_add(unsigned* p, unsigned v) { return __hip_atomic_fetch_add(p, v, __ATOMIC_RELAXED, __HIP_MEMORY_SCOPE_AGENT); }
__device__ __forceinline__ unsigned xb_xcc_id() { return (unsigned)__builtin_amdgcn_s_getreg((3 << 11) | 20) & 0xFu; }
#define XB_SPIN(cond, bar) do { unsigned _sp = 0; while (cond) { __builtin_amdgcn_s_sleep(1); \
    if ((++_sp & 255u) == 0u) { if (xb_ld(&(bar)[XB_TMO])) break; if (_sp > XB_SPIN_CAP) { atomicAdd(&(bar)[XB_TMO], 1u); break; } } } } while (0)
struct XcdBarrier { unsigned* bar; unsigned x; volatile LAS unsigned* st; };
__device__ __forceinline__ XcdBarrier xcd_barrier_post(unsigned* bar, volatile LAS unsigned* st) {
    XcdBarrier b; b.bar = bar; b.x = xb_xcc_id(); b.st = st;
    if (threadIdx.x == 0) (void)xb_add(&bar[XB_XCNT(b.x)], 1u);
    return b;
}
__device__ __forceinline__ void xcd_barrier_complete(unsigned* bar, unsigned x, unsigned& nloc, unsigned& nx) {
    const unsigned G = gridDim.x * gridDim.y * gridDim.z;
    unsigned sum, cnt, mine, sp = 0u;
    for (;;) {
        sum = 0u; cnt = 0u; mine = 0u;
#pragma unroll
        for (unsigned j = 0; j < 16; ++j) { const unsigned c = xb_ld(&bar[XB_XCNT(j)]); sum += c; cnt += (c > 0u) ? 1u : 0u; mine = (j == x) ? c : mine; }
        if (sum == G) break;
        __builtin_amdgcn_s_sleep(1);
        if ((++sp & 255u) == 0u) { if (xb_ld(&bar[XB_TMO])) break; if (sp > XB_SPIN_CAP) { atomicAdd(&bar[XB_TMO], 1u); break; } }
    }
    nloc = mine > 0u ? mine : 1u; nx = cnt > 0u ? cnt : 1u;
}
__device__ __forceinline__ void xcd_barrier(const XcdBarrier& b) {
    asm volatile("s_waitcnt vmcnt(0)" ::: "memory");
    __syncthreads();
    if (threadIdx.x == 0) {
        unsigned* bar = b.bar;
        __builtin_amdgcn_s_waitcnt(0);
        unsigned nloc = b.st[0], nx = b.st[1];
        if (nloc == 0u) { xcd_barrier_complete(bar, b.x, nloc, nx); b.st[0] = nloc; b.st[1] = nx; }
        const unsigned old = xb_add(&bar[XB_XSUB(b.x)], 1u);
        const unsigned gen = old / nloc;
        if (old + 1u == (gen + 1u) * nloc) {
            __builtin_amdgcn_fence(__ATOMIC_RELEASE, "agent");
            asm volatile("s_waitcnt vmcnt(0)" ::: "memory");
            const unsigned og = xb_add(&bar[XB_TOP], 1u);
            const unsigned tg = og / nx;
            if (og + 1u == (tg + 1u) * nx) xb_add(&bar[XB_TOPGEN], 1u);
            else XB_SPIN(xb_ld(&bar[XB_TOPGEN]) == tg, bar);
            __builtin_amdgcn_fence(__ATOMIC_ACQUIRE, "agent");
            xb_add(&bar[XB_XGEN(b.x)], 1u);
            asm volatile("s_waitcnt vmcnt(0)" ::: "memory");
        } else {
            XB_SPIN(xb_ld(&bar[XB_XGEN(b.x)]) == gen, bar);
            __builtin_amdgcn_fence(__ATOMIC_ACQUIRE, "agent");
            asm volatile("s_waitcnt vmcnt(0)" ::: "memory");
        }
    }
    __syncthreads();
}

#if defined(TS_SEL)
#ifndef TS_END
#define TS_END (TS_SEL + 1)
#endif
#ifndef TS_TID
#define TS_TID 0
#endif
#ifndef TS_BLK
#define TS_BLK 0
#endif
#ifndef TS_PH
#define TS_PH -1
#endif
#define STAMP(k) do { if ((k) == TS_SEL) F.ts0 = __builtin_amdgcn_s_memrealtime(); if ((k) == TS_END) F.ts1 = __builtin_amdgcn_s_memrealtime(); } while (0)
#else
#define STAMP(k) do { } while (0)
#endif
struct Args { const float* in[17]; float* out; unsigned char* ws; int ph_lo, ph_hi, li, pad; };
struct Frame {
    LAS unsigned char* lds; volatile LAS unsigned* MISC; unsigned* ctl;
    int tid, lane, wave, vcu, G; unsigned* cnt;
#if defined(TS_SEL)
    unsigned long long ts0, ts1;
#endif
    const float* in[17]; float* out; unsigned char* ws;
};

__device__ __forceinline__ void p0_transpose_item(const float* W, int ldw, h16* WT, int K, int k0, int n0, int drow0, LAS float* scr, int lane) {
    float tv[32];
#pragma unroll
    for (int i = 0; i < 32; ++i) tv[i] = W[(size_t)(k0 + 2 * i + (lane >> 5)) * ldw + n0 + (lane & 31)];
#pragma unroll
    for (int i = 0; i < 32; ++i) scr[(2 * i + (lane >> 5)) * 33 + (lane & 31)] = tv[i];
    LDS_WAIT(); asm volatile("" ::: "memory");
    const int c = lane & 7;
#pragma unroll
    for (int j = 0; j < 4; ++j) { const int n = (lane >> 3) + 8 * j; const LAS float* s = scr + (8 * c) * 33 + n;
        u32x4 o; o.x = pkh(s[0 * 33], s[1 * 33]); o.y = pkh(s[2 * 33], s[3 * 33]); o.z = pkh(s[4 * 33], s[5 * 33]); o.w = pkh(s[6 * 33], s[7 * 33]);
        *(u32x4*)(WT + (size_t)(drow0 + n) * K + k0 + 8 * c) = o; }
    LDS_WAIT(); asm volatile("" ::: "memory");
}
__device__ __forceinline__ void p0_prologue(Frame& F) {
    LAS float* scr = (LAS float*)(F.lds + F.wave * 16384);
    const int gw = F.vcu * 8 + F.wave, NGW = F.G * 8, lane = F.lane;
    unsigned char* ws = F.ws;
    constexpr int I_IN = 16 * 160, I_SB = 8 * 32, I_CV = 8 * 32, I_OUT = 16 * 32, I_G = 32 * 16 * 8, I_U = I_G, I_D = 32 * 4 * 32;
    constexpr int NITEMS = I_IN + I_SB + I_CV + I_OUT;
    for (int it = gw; it < NITEMS; it += NGW) {
        int r = it;
        if (r < I_IN) { const int kb = r / 160, nb = r % 160, n0 = nb * 32; int drow = n0;
            if (n0 < 1536) { const int tile = n0 >> 8, within = n0 & 255, wc = within >> 6, bj = (within >> 5) & 1; drow = tile * 256 + 128 * bj + 32 * wc; }
            p0_transpose_item(F.in[2], NPROJ, (h16*)(ws + WS_WIN), DM, kb * 64, n0, drow, scr, lane); continue; } r -= I_IN;
        if (r < I_SB) { const int kb = r / 32, nb = r % 32; p0_transpose_item(F.in[6], DM, (h16*)(ws + WS_WSB), AW, kb * 64, nb * 32, nb * 32, scr, lane); continue; } r -= I_SB;
        if (r < I_CV) { const int kb = r / 32, nb = r % 32; p0_transpose_item(F.in[7], DM, (h16*)(ws + WS_WCV), AW, kb * 64, nb * 32, nb * 32, scr, lane); continue; } r -= I_CV;
        { const int kb = r / 32, nb = r % 32; p0_transpose_item(F.in[8], DM, (h16*)(ws + WS_WOUT), DM, kb * 64, nb * 32, nb * 32, scr, lane); }
    }
    { float* RW = (float*)(ws + WS_RW); const float* g2 = F.in[9]; const float* wg = F.in[10]; const float* we = F.in[12];
      for (int i = (F.vcu * 8 + F.wave) * 64 + lane; i < 36 * 1024; i += F.G * 512) { const int c = i >> 10, k = i & 1023; RW[i] = g2[k] * (c < 4 ? wg[k * 4 + c] : we[k * 32 + (c - 4)]); } }
    { const float* g1 = F.in[1]; h16* H = (h16*)(ws + WS_H);
      f32x4 gv[4];
#pragma unroll
      for (int j = 0; j < 4; ++j) gv[j] = ((const f32x4*)g1)[lane + 64 * j];
      for (int m0 = gw; m0 < NTOK; m0 += 4 * NGW) {
        f32x4 v[4][4];
#pragma unroll
        for (int i = 0; i < 4; ++i) { const int m = m0 + i * NGW; const f32x4* xr = (const f32x4*)(F.in[0] + (size_t)(m < NTOK ? m : m0) * DM) + lane;
#pragma unroll
            for (int j = 0; j < 4; ++j) v[i][j] = xr[64 * j]; }
#pragma unroll
        for (int i = 0; i < 4; ++i) { const int m = m0 + i * NGW; if (m < NTOK) { float s = 0.f;
#pragma unroll
            for (int j = 0; j < 4; ++j) s += (v[i][j].x * v[i][j].x + v[i][j].y * v[i][j].y) + (v[i][j].z * v[i][j].z + v[i][j].w * v[i][j].w);
            const float rstd = rsqrtf(wave_total(s) * (1.f / DM) + EPS);
            u32x2* o8 = (u32x2*)(H + (size_t)m * DM) + lane;
#pragma unroll
            for (int j = 0; j < 4; ++j) { const f32x4 y = v[i][j] * rstd * gv[j]; u32x2 w; w.x = pkh(y.x, y.y); w.y = pkh(y.z, y.w); o8[64 * j] = w; } } }
      } }
}

struct XItem { const float* src; h16* dst; int ldw, K; };
__device__ __forceinline__ XItem expert_item(const Frame& F, int it) {
    constexpr int I_G = 32 * 16 * 8; XItem x; int r = it;
    if (r < 2 * I_G) { const int up = r >= I_G; if (up) r -= I_G; const int e = r / 128, q = r % 128, kb = q / 8, nb = q % 8, n0 = nb * 32;
        const int drow = 256 * (n0 >> 7) + 128 * up + (n0 & 127);
        x.src = F.in[up ? 15 : 14] + (size_t)e * DM * DEXP + (size_t)(kb * 64) * DEXP + n0; x.ldw = DEXP; x.K = DM;
        x.dst = (h16*)(F.ws + WS_W1) + ((size_t)e * 512 + drow) * DM + kb * 64; }
    else { r -= 2 * I_G; const int e = r / 128, q = r % 128, kb = q / 32, nb = q % 32;
        x.src = F.in[16] + (size_t)e * DEXP * DM + (size_t)(kb * 64) * DM + nb * 32; x.ldw = DM; x.K = DEXP;
        x.dst = (h16*)(F.ws + WS_W2) + ((size_t)e * DM + nb * 32) * DEXP + kb * 64; }
    return x;
}
__device__ __forceinline__ void convert_experts(Frame& F) {
    LAS float* scr = (LAS float*)(F.lds + F.wave * 16384);
    const int gw = F.vcu * 8 + F.wave, NGW = F.G * 8, lane = F.lane;
    constexpr int NIT = 2 * 32 * 16 * 8 + 32 * 4 * 32;
    if (gw >= NIT) return;
    XItem cur = expert_item(F, gw);
    float tv[32];
#pragma unroll
    for (int i = 0; i < 32; ++i) tv[i] = cur.src[(size_t)(2 * i + (lane >> 5)) * cur.ldw + (lane & 31)];
    for (int it = gw; it < NIT; it += NGW) {
        const int nx = it + NGW; const bool hn = nx < NIT;
        XItem nxt = cur; float tn[32];
        if (hn) { nxt = expert_item(F, nx);
#pragma unroll
            for (int i = 0; i < 32; ++i) tn[i] = nxt.src[(size_t)(2 * i + (lane >> 5)) * nxt.ldw + (lane & 31)]; }
#pragma unroll
        for (int i = 0; i < 32; ++i) scr[(2 * i + (lane >> 5)) * 33 + (lane & 31)] = tv[i];
        LDS_WAIT(); asm volatile("" ::: "memory");
        const int c = lane & 7;
#pragma unroll
        for (int j = 0; j < 4; ++j) { const int n = (lane >> 3) + 8 * j; const LAS float* p = scr + (8 * c) * 33 + n;
            u32x4 o; o.x = pkh(p[0 * 33], p[1 * 33]); o.y = pkh(p[2 * 33], p[3 * 33]); o.z = pkh(p[4 * 33], p[5 * 33]); o.w = pkh(p[6 * 33], p[7 * 33]);
            *(u32x4*)(cur.dst + (size_t)n * cur.K + 8 * c) = o; }
        LDS_WAIT(); asm volatile("" ::: "memory");
        if (hn) {
#pragma unroll
            for (int i = 0; i < 32; ++i) tv[i] = tn[i]; }
        cur = nxt;
    }
}

struct StaticOrder {
    const char* A; const char* Bt; int nM, nN, G, c; size_t tstep;
    __device__ __forceinline__ bool next(int i, Unit& u) const {
        const int L = i * G + c; if (L >= nM * nN) return false;
        int pm, pn; pg8::tile_of(L, nM, nN, pm, pn); u.pm = pm; u.pn = pn; u.e = 0; u.nrows = 256; u.lst = nullptr; u.wl = nullptr;
        u.a = A + (size_t)pm * tstep; u.b = Bt + (size_t)pn * tstep; return true;
    }
    __device__ __forceinline__ int tok(const Unit&, int) const { return 0; }
};
struct BranchOrder {
    const char* Aa; const char* Ab; const char* Ba; const char* Bb; int G, c;
    __device__ __forceinline__ bool next(int i, Unit& u) const {
        const int L = (i >> 1) * G + c; if (L >= 64 * 4) return false;
        int pm, pn; pg8::tile_of(L, 64, 4, pm, pn); u.pm = pm; u.pn = pn; u.e = i & 1; u.nrows = 256; u.lst = nullptr; u.wl = nullptr;
        const size_t tstep = (size_t)256 * AW * 2;
        u.a = ((i & 1) ? Ab : Aa) + (size_t)pm * tstep; u.b = ((i & 1) ? Bb : Ba) + (size_t)pn * tstep; return true;
    }
    __device__ __forceinline__ int tok(const Unit&, int) const { return 0; }
};
template <int NN, bool G1> struct MoeOrder {
    const LAS int* cntl; const char* A; const char* Bt; const int* tok_list; const float* w_list; int G, c;
    __device__ __forceinline__ bool next(int i, Unit& u) const {
        const int L = i * G + c, mtg = L / NN, pn = L % NN;
        int acc = 0, e = -1, mtl = 0, ce = 0;
        for (int j = 0; j < NEXP; ++j) { const int cj = cntl[j], t = (cj + 255) >> 8; if (e < 0 && mtg < acc + t) { e = j; mtl = mtg - acc; ce = cj; } acc += t; }
        if (e < 0) return false;
        e = __builtin_amdgcn_readfirstlane(e); mtl = __builtin_amdgcn_readfirstlane(mtl); ce = __builtin_amdgcn_readfirstlane(ce);
        u.pm = mtg; u.pn = pn; u.e = e; const int nr = ce - mtl * 256; u.nrows = nr < 256 ? nr : 256;
        u.lst = tok_list + (size_t)e * LCAP + mtl * 256; u.wl = w_list + (size_t)e * LCAP + mtl * 256;
        if (G1) { u.a = A; u.b = Bt + ((size_t)e * 512 + pn * 256) * DM * 2; }
        else { u.a = A + (size_t)mtg * 256 * DEXP * 2; u.b = Bt + ((size_t)e * DM + pn * 256) * DEXP * 2; }
        return true;
    }
    __device__ __forceinline__ int tok(const Unit& u, int r) const { return r < u.nrows ? u.lst[r] : 0; }
};

__device__ __forceinline__ u32x4 pack8(const f32x4 a, const f32x4 b) { u32x4 w; w.x = pkh(a[0], a[1]); w.y = pkh(a[2], a[3]); w.z = pkh(b[0], b[1]); w.w = pkh(b[2], b[3]); return w; }
__device__ __forceinline__ void unpack8(const u32x4 w, f32x4& a, f32x4& b) {
    const h16x8 h = __builtin_bit_cast(h16x8, w);
    a = (f32x4){(float)h[0], (float)h[1], (float)h[2], (float)h[3]}; b = (f32x4){(float)h[4], (float)h[5], (float)h[6], (float)h[7]};
}
struct EpiProj {
    static constexpr bool PERM = true;
    unsigned char* ws; const float* qg; const float* kg;
    __device__ __forceinline__ void operator()(const f32x4 (&acc)[2][2][4][2], const Unit& u, int wr, int wc, int fr, int fq) const {
        const int row0 = u.pm * 256 + wr * 64 + fr, pn = u.pn;
        if (pn < 4) {
            const bool isq = pn < 2; const int head = 4 * (pn & 1) + wc; const float* gp = isq ? qg : kg; const float sc = isq ? 0.125f * 1.4426950408889634f : 1.0f;
            h16* dst = (h16*)(ws + (isq ? WS_Q : WS_K));
            const f32x4 g00 = *(const f32x4*)(gp + 8 * fq), g01 = *(const f32x4*)(gp + 8 * fq + 4), g10 = *(const f32x4*)(gp + 32 + 8 * fq), g11 = *(const f32x4*)(gp + 32 + 8 * fq + 4);
#pragma unroll
            for (int ai = 0; ai < 2; ++ai)
#pragma unroll
                for (int m = 0; m < 4; ++m) {
                    const f32x4 a0 = acc[ai][0][m][0], a1 = acc[ai][0][m][1], b0 = acc[ai][1][m][0], b1 = acc[ai][1][m][1];
                    float ss = (a0[0] * a0[0] + a0[1] * a0[1]) + (a0[2] * a0[2] + a0[3] * a0[3]) + (a1[0] * a1[0] + a1[1] * a1[1]) + (a1[2] * a1[2] + a1[3] * a1[3])
                             + (b0[0] * b0[0] + b0[1] * b0[1]) + (b0[2] * b0[2] + b0[3] * b0[3]) + (b1[0] * b1[0] + b1[1] * b1[1]) + (b1[2] * b1[2] + b1[3] * b1[3]);
                    ss += __shfl_xor(ss, 16); ss += __shfl_xor(ss, 32);
                    const float r = rsqrtf(ss * (1.f / HD) + EPS) * sc;
                    h16* rowp = dst + (size_t)(row0 + ai * 128 + m * 16) * AW + head * HD + 8 * fq;
                    __builtin_nontemporal_store(pack8(a0 * r * g00, a1 * r * g01), (u32x4*)(rowp));
                    __builtin_nontemporal_store(pack8(b0 * r * g10, b1 * r * g11), (u32x4*)(rowp + 32));
                }
        } else if (pn < 6) {
            const int head = 4 * (pn & 1) + wc; h16* VT = (h16*)(ws + WS_VT);
            const int pf = fr ^ ((((fr >> 2) ^ (fr >> 3)) & 1) ? 12 : 0);
#pragma unroll
            for (int ai = 0; ai < 2; ++ai)
#pragma unroll
                for (int m = 0; m < 4; ++m) {
                    const int row = row0 + ai * 128 + m * 16, b = row >> 12, s = row & (SEQ - 1);
                    h16* colp = VT + ((size_t)(b * NH + head) * HD + 8 * fq) * SEQ + (s & ~15) + pf;
#pragma unroll
                    for (int bj = 0; bj < 2; ++bj)
#pragma unroll
                        for (int n = 0; n < 2; ++n)
#pragma unroll
                            for (int j = 0; j < 4; ++j) colp[(size_t)(32 * bj + 4 * n + j) * SEQ] = (h16)acc[ai][bj][m][n][j];
                }
        } else {
            const bool gate = pn >= 12; h16* dst; int ldc, col0;
            if (!gate) { const int w = (pn - 6) >> 1; dst = (h16*)(ws + WS_CB + (size_t)w * 16 * MiB); ldc = AW; col0 = ((pn - 6) & 1) * 256; }
            else { const int w = (pn - 12) >> 2; dst = (h16*)(ws + WS_GA + (size_t)w * 32 * MiB); ldc = DM; col0 = ((pn - 12) & 3) * 256; }
            col0 += wc * 32 + 8 * fq;
#pragma unroll
            for (int ai = 0; ai < 2; ++ai)
#pragma unroll
                for (int m = 0; m < 4; ++m) { h16* rowp = dst + (size_t)(row0 + ai * 128 + m * 16) * ldc + col0;
#pragma unroll
                    for (int bj = 0; bj < 2; ++bj) { f32x4 v0 = acc[ai][bj][m][0], v1 = acc[ai][bj][m][1];
                        if (gate) {
#pragma unroll
                            for (int j = 0; j < 4; ++j) { v0[j] = sigmoidf_(v0[j]); v1[j] = sigmoidf_(v1[j]); } }
                        __builtin_nontemporal_store(pack8(v0, v1), (u32x4*)(rowp + bj * 128)); } }
        }
    }
};
struct EpiBranch {
    static constexpr bool PERM = true;
    unsigned char* ws;
    __device__ __forceinline__ void operator()(const f32x4 (&acc)[2][2][4][2], const Unit& u, int wr, int wc, int fr, int fq) const {
        const int row0 = u.pm * 256 + wr * 64 + fr; const int col0 = u.pn * 256 + wc * 32 + 8 * fq; const bool second = u.e != 0;
        const h16* gt = (const h16*)(ws + (second ? WS_GB : WS_GA)); h16* H = (h16*)(ws + WS_MRG);
#pragma unroll
        for (int ai = 0; ai < 2; ++ai) {
            u32x4 gq[4][2], hq[4][2];
#pragma unroll
            for (int m = 0; m < 4; ++m)
#pragma unroll
                for (int bj = 0; bj < 2; ++bj) { const size_t off = (size_t)(row0 + ai * 128 + m * 16) * DM + col0 + bj * 128; gq[m][bj] = *(const u32x4*)(gt + off); if (second) hq[m][bj] = *(const u32x4*)(H + off); }
#pragma unroll
            for (int m = 0; m < 4; ++m)
#pragma unroll
                for (int bj = 0; bj < 2; ++bj) { const size_t off = (size_t)(row0 + ai * 128 + m * 16) * DM + col0 + bj * 128; f32x4 g0, g1; unpack8(gq[m][bj], g0, g1);
                    f32x4 v0 = acc[ai][bj][m][0] * g0, v1 = acc[ai][bj][m][1] * g1;
                    if (second) { f32x4 p0, p1; unpack8(hq[m][bj], p0, p1); v0 += p0; v1 += p1; }
                    *(u32x4*)(H + off) = pack8(v0, v1); } }
    }
};
struct EpiOut {
    static constexpr bool PERM = false;
    const float* x; float* out;
    __device__ __forceinline__ void operator()(const f32x4 (&acc)[2][2][4][2], const Unit& u, int wr, int wc, int fr, int fq) const {
        const int row0 = u.pm * 256 + wr * 64 + fr, col0 = u.pn * 256 + wc * 32 + 4 * fq;
#pragma unroll
        for (int ai = 0; ai < 2; ++ai) {
            f32x4 xv[4][2][2];
#pragma unroll
            for (int m = 0; m < 4; ++m)
#pragma unroll
                for (int bj = 0; bj < 2; ++bj)
#pragma unroll
                    for (int n = 0; n < 2; ++n) xv[m][bj][n] = *(const f32x4*)(x + (size_t)(row0 + ai * 128 + m * 16) * DM + col0 + bj * 128 + n * 16);
#pragma unroll
            for (int m = 0; m < 4; ++m)
#pragma unroll
                for (int bj = 0; bj < 2; ++bj)
#pragma unroll
                    for (int n = 0; n < 2; ++n) *(f32x4*)(out + (size_t)(row0 + ai * 128 + m * 16) * DM + col0 + bj * 128 + n * 16) = xv[m][bj][n] + acc[ai][bj][m][n]; }
    }
};
struct EpiAct {
    static constexpr bool PERM = true;
    h16* act;
    __device__ __forceinline__ void operator()(const f32x4 (&acc)[2][2][4][2], const Unit& u, int wr, int wc, int fr, int fq) const {
        const int r0 = wr * 64 + fr; const int col0 = u.pn * 128 + wc * 32 + 8 * fq;
        float wv[2][4];
#pragma unroll
        for (int ai = 0; ai < 2; ++ai)
#pragma unroll
            for (int m = 0; m < 4; ++m) { const int r = r0 + ai * 128 + m * 16; wv[ai][m] = r < u.nrows ? u.wl[r] : 0.f; }
#pragma unroll
        for (int ai = 0; ai < 2; ++ai)
#pragma unroll
            for (int m = 0; m < 4; ++m) { const int r = r0 + ai * 128 + m * 16; const float w = wv[ai][m];
                f32x4 v0, v1;
#pragma unroll
                for (int j = 0; j < 4; ++j) { const float g0 = acc[ai][0][m][0][j], g1 = acc[ai][0][m][1][j];
                    v0[j] = g0 * sigmoidf_(g0) * acc[ai][1][m][0][j] * w; v1[j] = g1 * sigmoidf_(g1) * acc[ai][1][m][1][j] * w; }
                *(u32x4*)(act + (size_t)(u.pm * 256 + r) * DEXP + col0) = pack8(v0, v1); }
    }
};
struct EpiY {
    static constexpr bool PERM = true;
    h16* y;
    __device__ __forceinline__ void operator()(const f32x4 (&acc)[2][2][4][2], const Unit& u, int wr, int wc, int fr, int fq) const {
        const int row0 = u.pm * 256 + wr * 64 + fr, col0 = u.pn * 256 + wc * 32 + 8 * fq;
#pragma unroll
        for (int ai = 0; ai < 2; ++ai)
#pragma unroll
            for (int m = 0; m < 4; ++m) { h16* rowp = y + (size_t)(row0 + ai * 128 + m * 16) * DM + col0;
#pragma unroll
                for (int bj = 0; bj < 2; ++bj) *(u32x4*)(rowp + bj * 128) = pack8(acc[ai][bj][m][0], acc[ai][bj][m][1]); }
    }
};

constexpr float SB_EXIT = 25.0f;
__device__ __forceinline__ void attn_stage(LAS unsigned char* st, const h16* kbase, const h16* vbase, int kt) {
#pragma unroll
    for (int s = 0; s < 4; ++s) __builtin_amdgcn_global_load_lds((const unsigned*)(kbase + (size_t)(kt * 32) * AW + 16 * s), (LAS unsigned*)(st + s * 1024), 16, 0, 0);
#pragma unroll
    for (int db = 0; db < 2; ++db)
#pragma unroll
        for (int s2 = 0; s2 < 2; ++s2) __builtin_amdgcn_global_load_lds((const unsigned*)(vbase + (size_t)(32 * db) * SEQ + kt * 32 + 16 * s2), (LAS unsigned*)(st + (4 + 2 * db + s2) * 1024), 16, 0, 0);
}
__device__ __forceinline__ void sb_block(const f32x16& p, float& run, const bool diag, const int r, const int hh, h16x8& bp0, h16x8& bp1) {
    float sp[16];
#pragma unroll
    for (int i = 0; i < 16; ++i) { const float z = p[i]; float v = fmaxf(z, 0.f) + __builtin_amdgcn_logf(1.0f + __builtin_amdgcn_exp2f(-fabsf(z)));
        if (diag) { const int key = (i & 3) + 8 * (i >> 2) + 4 * hh; v = key < r ? v : 0.f; }
        sp[i] = v; }
    float G[4], Go[4], T[4];
#pragma unroll
    for (int g = 0; g < 4; ++g) { G[g] = (sp[4 * g] + sp[4 * g + 1]) + (sp[4 * g + 2] + sp[4 * g + 3]); Go[g] = __shfl_xor(G[g], 32); T[g] = G[g] + Go[g]; }
    float base[4];
    base[3] = run; base[2] = run + T[3]; base[1] = base[2] + T[2]; base[0] = base[1] + T[1];
    float a[16];
#pragma unroll
    for (int g = 0; g < 4; ++g) { float t = base[g] + (hh == 0 ? Go[g] : 0.f);
#pragma unroll
        for (int w = 3; w >= 0; --w) { const int i = 4 * g + w; float e = __builtin_amdgcn_exp2f(p[i] - sp[i] - t);
            if (diag) { const int key = (i & 3) + 8 * (i >> 2) + 4 * hh; e = key < r ? e : 0.f; }
            a[i] = e; t += sp[i]; } }
    run = base[0] + T[0];
#pragma unroll
    for (int j = 0; j < 8; ++j) { bp0[j] = (h16)a[j]; bp1[j] = (h16)a[8 + j]; }
}
__device__ __forceinline__ void attn_task(Frame& F, int b, int h, int m, const h16* Q, const h16* Kb, const h16* VT, h16* AO, LAS unsigned char* stage, int lane) {
    STAMP(30);
    const int r = lane & 31, hh = lane >> 5;
    const size_t tb = (size_t)b * SEQ;
    const h16* kbase = Kb + (tb + r) * AW + h * HD + 8 * hh;
    const h16* vbase = VT + ((size_t)(b * NH + h) * HD + r) * SEQ + 8 * hh;
    const int ktop = 2 * m + 1;
    attn_stage(stage, kbase, vbase, ktop);
    const h16* qrow = Q + (tb + m * 64 + r) * AW + h * HD + 8 * hh;
    h16x8 bqA[4], bqB[4];
#pragma unroll
    for (int s = 0; s < 4; ++s) { bqA[s] = *(const h16x8*)(qrow + 16 * s); bqB[s] = *(const h16x8*)(qrow + (size_t)32 * AW + 16 * s); }
    f32x16 oA0 = {}, oA1 = {}, oB0 = {}, oB1 = {}; float runA = 0.f, runB = 0.f;
    int buf = 0;
    for (int kt = ktop; kt >= 0; --kt) {
        const LAS unsigned char* st = stage + buf * 8192 + lane * 16;
        h16x8 ak[4], av[2][2];
        VM_WAIT(); if (kt == ktop) STAMP(31);
#pragma unroll
        for (int s = 0; s < 4; ++s) ak[s] = *(const LAS h16x8*)(st + s * 1024);
#pragma unroll
        for (int db = 0; db < 2; ++db)
#pragma unroll
            for (int s2 = 0; s2 < 2; ++s2) av[db][s2] = *(const LAS h16x8*)(st + (4 + 2 * db + s2) * 1024);
        buf ^= 1;
        attn_stage(stage + buf * 8192, kbase, vbase, kt > 0 ? kt - 1 : 0);
        const bool actA = kt < ktop;
        f32x16 pB = {}, pA = {};
#pragma unroll
        for (int s = 0; s < 4; ++s) pB = __builtin_amdgcn_mfma_f32_32x32x16_f16(ak[s], bqB[s], pB, 0, 0, 0);
        if (actA) {
#pragma unroll
            for (int s = 0; s < 4; ++s) pA = __builtin_amdgcn_mfma_f32_32x32x16_f16(ak[s], bqA[s], pA, 0, 0, 0); }
        h16x8 bp0, bp1;
        sb_block(pB, runB, kt == ktop, r, hh, bp0, bp1);
        oB0 = __builtin_amdgcn_mfma_f32_32x32x16_f16(av[0][0], bp0, oB0, 0, 0, 0);
        oB0 = __builtin_amdgcn_mfma_f32_32x32x16_f16(av[0][1], bp1, oB0, 0, 0, 0);
        oB1 = __builtin_amdgcn_mfma_f32_32x32x16_f16(av[1][0], bp0, oB1, 0, 0, 0);
        oB1 = __builtin_amdgcn_mfma_f32_32x32x16_f16(av[1][1], bp1, oB1, 0, 0, 0);
        if (actA) {
            sb_block(pA, runA, kt == ktop - 1, r, hh, bp0, bp1);
            oA0 = __builtin_amdgcn_mfma_f32_32x32x16_f16(av[0][0], bp0, oA0, 0, 0, 0);
            oA0 = __builtin_amdgcn_mfma_f32_32x32x16_f16(av[0][1], bp1, oA0, 0, 0, 0);
            oA1 = __builtin_amdgcn_mfma_f32_32x32x16_f16(av[1][0], bp0, oA1, 0, 0, 0);
            oA1 = __builtin_amdgcn_mfma_f32_32x32x16_f16(av[1][1], bp1, oA1, 0, 0, 0);
            if (__all(runA > SB_EXIT && runB > SB_EXIT)) break; }
    }
    STAMP(32);
    VM_WAIT();
    STAMP(33);
    h16* orow = AO + (tb + m * 64 + r) * AW + h * HD + 4 * hh;
#pragma unroll
    for (int g = 0; g < 4; ++g) {
        u32x2 w; w.x = pkh(oA0[4 * g], oA0[4 * g + 1]); w.y = pkh(oA0[4 * g + 2], oA0[4 * g + 3]); *(u32x2*)(orow + 8 * g) = w;
        w.x = pkh(oA1[4 * g], oA1[4 * g + 1]); w.y = pkh(oA1[4 * g + 2], oA1[4 * g + 3]); *(u32x2*)(orow + 32 + 8 * g) = w;
        w.x = pkh(oB0[4 * g], oB0[4 * g + 1]); w.y = pkh(oB0[4 * g + 2], oB0[4 * g + 3]); *(u32x2*)(orow + (size_t)32 * AW + 8 * g) = w;
        w.x = pkh(oB1[4 * g], oB1[4 * g + 1]); w.y = pkh(oB1[4 * g + 2], oB1[4 * g + 3]); *(u32x2*)(orow + (size_t)32 * AW + 32 + 8 * g) = w; }
    STAMP(34);
}
__device__ __forceinline__ void p2_attn_conv(Frame& F) {
    const int gw = F.vcu * 8 + F.wave, NGW = F.G * 8, lane = F.lane;
    const h16* Q = (const h16*)(F.ws + WS_Q); h16* AO = (h16*)(F.ws + WS_AO); const h16* Kb = (const h16*)(F.ws + WS_K); const h16* VT = (const h16*)(F.ws + WS_VT);
    STAMP(20);
    for (int t = gw; t < 32 * 64; t += NGW) { const int bh = t >> 6, j = t & 63, m = (j & 1) ? (63 - (j >> 1)) : (j >> 1);
        attn_task(F, bh >> 3, bh & 7, m, Q, Kb, VT, AO, F.lds + F.wave * 16384, lane); }
    STAMP(21);
    STAMP(22);
    const h16* CB = (const h16*)(F.ws + WS_CB); h16* CO = (h16*)(F.ws + WS_CO); const h16* CC = (const h16*)(F.ws + WS_CC); const h16* CU = (const h16*)(F.ws + WS_CU); const float* cw = F.in[5];
    f32x4 w0a = *(const f32x4*)(cw + 8 * lane), w0b = *(const f32x4*)(cw + 8 * lane + 4), w1a = *(const f32x4*)(cw + AW + 8 * lane), w1b = *(const f32x4*)(cw + AW + 8 * lane + 4),
          w2a = *(const f32x4*)(cw + 2 * AW + 8 * lane), w2b = *(const f32x4*)(cw + 2 * AW + 8 * lane + 4);
    for (int c = gw; c < NTOK / 8; c += NGW) { const int t0 = c * 8; const bool first = (t0 & (SEQ - 1)) == 0;
        u32x4 rc[10], ru[10], rb[8];
#pragma unroll
        for (int i = 0; i < 10; ++i) { const int t = t0 - 2 + i; const size_t off = (size_t)((i < 2 && first) ? t0 : t) * AW + 8 * lane; rc[i] = *(const u32x4*)(CC + off); ru[i] = *(const u32x4*)(CU + off); }
#pragma unroll
        for (int i = 0; i < 8; ++i) rb[i] = *(const u32x4*)(CB + (size_t)(t0 + i) * AW + 8 * lane);
        f32x4 pa2, pb2, pa1, pb1;
        { f32x4 x0, x1, y0, y1; unpack8(rc[0], x0, x1); unpack8(ru[0], y0, y1); pa2 = x0 * y0; pb2 = x1 * y1; unpack8(rc[1], x0, x1); unpack8(ru[1], y0, y1); pa1 = x0 * y0; pb1 = x1 * y1; }
        if (first) { pa2 = (f32x4){0.f, 0.f, 0.f, 0.f}; pb2 = pa2; pa1 = pa2; pb1 = pa2; }
#pragma unroll
        for (int i = 0; i < 8; ++i) { f32x4 x0, x1, y0, y1, b0, b1;
            unpack8(rc[i + 2], x0, x1); unpack8(ru[i + 2], y0, y1); unpack8(rb[i], b0, b1);
            const f32x4 pa0 = x0 * y0, pb0 = x1 * y1;
            const f32x4 ya = b0 * (w0a * pa2 + w1a * pa1 + w2a * pa0), yb = b1 * (w0b * pb2 + w1b * pb1 + w2b * pb0);
            *(u32x4*)(CO + (size_t)(t0 + i) * AW + 8 * lane) = pack8(ya, yb);
            pa2 = pa1; pb2 = pb1; pa1 = pa0; pb1 = pb0; } }
    STAMP(23);
}

__device__ __forceinline__ float reduce4(float s0, float s1, float s2, float s3, const bool b0, const bool b1) {
    const float t0 = (b0 ? s1 : s0) + dpp_mov<0xB1, 0xf>(b0 ? s0 : s1);
    const float t1 = (b0 ? s3 : s2) + dpp_mov<0xB1, 0xf>(b0 ? s2 : s3);
    float u = (b1 ? t1 : t0) + dpp_mov<0x4E, 0xf>(b1 ? t0 : t1);
    u += dpp_mov<0x124, 0xf>(u); u += dpp_mov<0x128, 0xf>(u);
    u += __builtin_bit_cast(float, __builtin_amdgcn_ds_swizzle(__builtin_bit_cast(int, u), 0x401F));
    u += __shfl_xor(u, 32);
    return u;
}
__device__ __forceinline__ float dot16(const f32x4 (&v)[4], const LAS float* w) {
    float a = 0.f;
#pragma unroll
    for (int j = 0; j < 4; ++j) { const f32x4 x = *(const LAS f32x4*)(w + 256 * j); a += (v[j].x * x.x + v[j].y * x.y) + (v[j].z * x.z + v[j].w * x.w); }
    return a;
}
__device__ __forceinline__ void p5_router(Frame& F) {
    const int gw = F.vcu * 8 + F.wave, NGW = F.G * 8, lane = F.lane;
    STAMP(50);
    LAS float* RW = (LAS float*)F.lds;
    { const unsigned char* src = F.ws + WS_RW + lane * 16;
#pragma unroll
      for (int i = 0; i < 18; ++i) __builtin_amdgcn_global_load_lds((const unsigned*)(src + (F.wave * 18 + i) * 1024), (LAS unsigned*)(F.lds + (F.wave * 18 + i) * 1024), 16, 0, 0); }
    LAS unsigned* lcnt = (LAS unsigned*)(F.MISC + 128); LAS unsigned* lbase = (LAS unsigned*)(F.MISC + 160);
    const float* g2 = F.in[9]; const float* bg = F.in[11]; const float* be = F.in[13];
    h16* H = (h16*)(F.ws + WS_H); int* TOK = (int*)(F.ws + WS_TOK); float* WL = (float*)(F.ws + WS_WL); i32x4* ROUTE = (i32x4*)(F.ws + WS_ROUTE);
    const bool b0 = lane & 1, b1 = (lane >> 1) & 1;
    VM_WAIT();
    f32x4 gv[4];
#pragma unroll
    for (int j = 0; j < 4; ++j) gv[j] = ((const f32x4*)g2)[lane + 64 * j];
    const float bgl[4] = {bg[0], bg[1], bg[2], bg[3]};
    for (int base = 0; base < NTOK; base += NGW * 8) {
        if (F.tid < NEXP) lcnt[F.tid] = 0u;
        __syncthreads();
        STAMP(51);
        int ke0 = 0, ke1 = 0, km = -1; float kw0 = 0.f, kw1 = 0.f;
#pragma unroll 1
        for (int ps = 0; ps < 2; ++ps) {
            const int mb = base + gw + (4 * ps) * NGW;
            f32x4 v[4][4];
#pragma unroll
            for (int i = 0; i < 4; ++i) { const int m = mb + i * NGW; const f32x4* xr = (const f32x4*)(F.out + (size_t)(m < NTOK ? m : 0) * DM) + lane;
#pragma unroll
                for (int j = 0; j < 4; ++j) v[i][j] = xr[64 * j]; }
            float ss[4];
#pragma unroll
            for (int i = 0; i < 4; ++i) { float s = 0.f;
#pragma unroll
                for (int j = 0; j < 4; ++j) s += (v[i][j].x * v[i][j].x + v[i][j].y * v[i][j].y) + (v[i][j].z * v[i][j].z + v[i][j].w * v[i][j].w);
                ss[i] = s; }
            const float rstd = rsqrtf(reduce4(ss[0], ss[1], ss[2], ss[3], b0, b1) * (1.f / DM) + EPS);
#pragma unroll
            for (int i = 0; i < 4; ++i) { const int m = mb + i * NGW; if (m < NTOK) {
                const float ri = __builtin_bit_cast(float, __builtin_amdgcn_readlane(__builtin_bit_cast(int, rstd), i));
                u32x2* o8 = (u32x2*)(H + (size_t)m * DM) + lane;
#pragma unroll
                for (int j = 0; j < 4; ++j) { const f32x4 y = v[i][j] * ri * gv[j]; u32x2 w; w.x = pkh(y.x, y.y); w.y = pkh(y.z, y.w); o8[64 * j] = w; } } }
            float lg[4];
#pragma unroll
            for (int c = 0; c < 4; ++c) { const LAS float* w = RW + c * 1024 + 4 * lane;
                lg[c] = reduce4(dot16(v[0], w), dot16(v[1], w), dot16(v[2], w), dot16(v[3], w), b0, b1) * rstd + bgl[c]; }
            int gi = 0; float gm = lg[0];
#pragma unroll
            for (int c = 1; c < 4; ++c) if (lg[c] > gm) { gm = lg[c]; gi = c; }
            float den = 0.f;
#pragma unroll
            for (int c = 0; c < 4; ++c) den += __expf(lg[c] - gm);
            const float gwt = 1.0f / den;
            int gr[4];
#pragma unroll
            for (int i = 0; i < 4; ++i) gr[i] = __builtin_amdgcn_readlane(gi, i);
            float ev[8];
#pragma unroll
            for (int c = 0; c < 8; ++c) {
                const float s0 = dot16(v[0], RW + (4 + 8 * gr[0] + c) * 1024 + 4 * lane), s1 = dot16(v[1], RW + (4 + 8 * gr[1] + c) * 1024 + 4 * lane),
                            s2 = dot16(v[2], RW + (4 + 8 * gr[2] + c) * 1024 + 4 * lane), s3 = dot16(v[3], RW + (4 + 8 * gr[3] + c) * 1024 + 4 * lane);
                ev[c] = reduce4(s0, s1, s2, s3, b0, b1) * rstd + be[8 * gi + c];
                if (c & 1) asm volatile("" ::: "memory"); }
            int i0 = 0; float v0 = ev[0];
#pragma unroll
            for (int c = 1; c < 8; ++c) if (ev[c] > v0) { v0 = ev[c]; i0 = c; }
            int i1 = -1; float v1 = -INFINITY;
#pragma unroll
            for (int c = 0; c < 8; ++c) if (c != i0 && ev[c] > v1) { v1 = ev[c]; i1 = c; }
            const float e1 = __expf(v1 - v0), w0 = gwt / (1.0f + e1), w1 = gwt * e1 / (1.0f + e1);
            const int mrow = mb + (lane & 3) * NGW;
            if ((lane >> 2) == ps && mrow < NTOK) { ke0 = gi * 8 + i0; ke1 = gi * 8 + i1; kw0 = w0; kw1 = w1; km = mrow; }
        }
        STAMP(52);
        unsigned p0 = 0, p1 = 0;
        if (km >= 0) { p0 = __hip_atomic_fetch_add(lcnt + ke0, 1u, __ATOMIC_RELAXED, __HIP_MEMORY_SCOPE_WORKGROUP); p1 = __hip_atomic_fetch_add(lcnt + ke1, 1u, __ATOMIC_RELAXED, __HIP_MEMORY_SCOPE_WORKGROUP); }
        __syncthreads();
        if (F.tid < NEXP) { const unsigned c = lcnt[F.tid]; lbase[F.tid] = c ? atomicAdd(F.cnt + 64 * F.tid, c) : 0u; }
        __syncthreads();
        if (km >= 0) { const int q0 = (int)(lbase[ke0] + p0), q1 = (int)(lbase[ke1] + p1);
            TOK[(size_t)ke0 * LCAP + q0] = km; WL[(size_t)ke0 * LCAP + q0] = kw0; TOK[(size_t)ke1 * LCAP + q1] = km; WL[(size_t)ke1 * LCAP + q1] = kw1;
            ROUTE[km] = (i32x4){ke0, q0, ke1, q1}; }
        __syncthreads();
        STAMP(53);
    }
}
__device__ __forceinline__ void load_counts(Frame& F) {
    __syncthreads();
    if (F.tid < NEXP) F.MISC[64 + F.tid] = __hip_atomic_load(F.cnt + 64 * F.tid, __ATOMIC_RELAXED, __HIP_MEMORY_SCOPE_AGENT);
    __syncthreads();
}
__device__ __forceinline__ void p8_combine(Frame& F) {
    const int gw = F.vcu * 8 + F.wave, NGW = F.G * 8, lane = F.lane;
    const LAS int* cntl = (const LAS int*)(F.MISC + 64); LAS int* pbase = (LAS int*)(F.MISC + 96);
    if (F.tid < NEXP) { int acc = 0; for (int j = 0; j < F.tid; ++j) acc += ((cntl[j] + 255) >> 8) << 8; pbase[F.tid] = acc; }
    __syncthreads();
    const h16* Y = (const h16*)(F.ws + WS_Y); const i32x4* ROUTE = (const i32x4*)(F.ws + WS_ROUTE);
    for (int base = 0; base < NTOK; base += NGW * 8) {
        int r0 = 0, r1 = 0;
        { const int m = base + gw + (lane & 7) * NGW; if (m < NTOK) { const i32x4 rt = ROUTE[m]; r0 = pbase[rt.x] + rt.y; r1 = pbase[rt.z] + rt.w; } }
#pragma unroll
        for (int i4 = 0; i4 < 8; i4 += 4) {
            f32x4 xv[4][4]; u32x2 ya[4][4], yb[4][4];
#pragma unroll
            for (int i = 0; i < 4; ++i) { const int m = base + gw + (i4 + i) * NGW; const int mm = m < NTOK ? m : 0;
                const size_t q0 = (size_t)__builtin_amdgcn_readlane(r0, i4 + i), q1 = (size_t)__builtin_amdgcn_readlane(r1, i4 + i);
                const f32x4* xr = (const f32x4*)(F.out + (size_t)mm * DM) + lane; const u32x2* y0 = (const u32x2*)(Y + q0 * DM) + lane; const u32x2* y1 = (const u32x2*)(Y + q1 * DM) + lane;
#pragma unroll
                for (int j = 0; j < 4; ++j) { xv[i][j] = xr[64 * j]; ya[i][j] = y0[64 * j]; yb[i][j] = y1[64 * j]; } }
#pragma unroll
            for (int i = 0; i < 4; ++i) { const int m = base + gw + (i4 + i) * NGW; if (m < NTOK) { f32x4* xr = (f32x4*)(F.out + (size_t)m * DM) + lane;
#pragma unroll
                for (int j = 0; j < 4; ++j) { f32x4 v = xv[i][j]; const h16x4 a = __builtin_bit_cast(h16x4, ya[i][j]), b = __builtin_bit_cast(h16x4, yb[i][j]);
                    v.x += (float)a[0] + (float)b[0]; v.y += (float)a[1] + (float)b[1]; v.z += (float)a[2] + (float)b[2]; v.w += (float)a[3] + (float)b[3]; xr[64 * j] = v; } } }
        }
    }
}

__global__ void __launch_bounds__(512, 2) hsb_fwd(Args args) {
    extern __shared__ __attribute__((aligned(16))) unsigned char lds[];
    Frame F;
    F.lds = (LAS unsigned char*)lds; F.MISC = (volatile LAS unsigned*)(F.lds + MISC_OFF);
    F.tid = threadIdx.x; F.lane = F.tid & 63; F.wave = __builtin_amdgcn_readfirstlane(F.tid >> 6);
    F.G = gridDim.x; { const int bx = blockIdx.x; F.vcu = (F.G % 8 == 0) ? (bx % 8) * (F.G / 8) + bx / 8 : bx; }
#pragma unroll
    for (int i = 0; i < 17; ++i) F.in[i] = args.in[i];
    F.out = args.out; F.ws = args.ws; F.ctl = (unsigned*)(args.ws + WS_CTL); F.cnt = F.ctl + CW_CNT + args.li * 64 * NEXP;
    for (int u = F.tid; u < 256; u += 512) ((LAS unsigned*)(F.lds + MISC_OFF))[u] = 0u;
    __syncthreads();
    XcdBarrier bar = xcd_barrier_post(F.ctl + CW_BAR + args.li * XCD_BAR_WORDS, F.MISC + 8);
    const int lo = args.ph_lo, hi = args.ph_hi;
#ifndef PH_MASK
#define PH_MASK 0x1ff
#endif
#define IN(k) (((PH_MASK >> (k)) & 1) && lo <= (k) && (k) < hi)
#define SEAM(k) do { if (IN(k) && IN((k) + 1)) xcd_barrier(bar); } while (0)
    unsigned char* ws = args.ws;

#if defined(TS_SEL)
    F.ts0 = 0; F.ts1 = 0;
#define TSP (&F.ts0)
#else
#define TSP nullptr
#endif
    STAMP(0);
    if (IN(0)) { p0_prologue(F); convert_experts(F); } SEAM(0); STAMP(1);
    if (IN(1)) {
        StaticOrder S{(const char*)(ws + WS_H), (const char*)(ws + WS_WIN), NTOK / 256, NPROJ / 256, F.G, (int)blockIdx.x, (size_t)256 * DM * 2};
        EpiProj E{ws, F.in[3], F.in[4]};
        pg8::gemm_phase<EpiProj, StaticOrder, false, 1>(F.lds, DM, S, E, TSP);
    } SEAM(1); STAMP(2);
    if (IN(2)) { p2_attn_conv(F); } SEAM(2); STAMP(3);
    if (IN(3)) {
        BranchOrder S{(const char*)(ws + WS_AO), (const char*)(ws + WS_CO), (const char*)(ws + WS_WSB), (const char*)(ws + WS_WCV), F.G, (int)blockIdx.x};
        EpiBranch E{ws};
        pg8::gemm_phase<EpiBranch, BranchOrder, false, 3>(F.lds, AW, S, E, TSP);
    } SEAM(3); STAMP(4);
    if (IN(4)) {
        StaticOrder S{(const char*)(ws + WS_MRG), (const char*)(ws + WS_WOUT), NTOK / 256, DM / 256, F.G, (int)blockIdx.x, (size_t)256 * DM * 2};
        EpiOut E{F.in[0], F.out};
        pg8::gemm_phase<EpiOut, StaticOrder, false, 4>(F.lds, DM, S, E, TSP);
    } SEAM(4); STAMP(5);
    if (IN(5)) { p5_router(F); } SEAM(5); STAMP(6);
    if (IN(6)) {
        load_counts(F);
        MoeOrder<2, true> S{(const LAS int*)(F.MISC + 64), (const char*)(ws + WS_H), (const char*)(ws + WS_W1), (const int*)(ws + WS_TOK), (const float*)(ws + WS_WL), F.G, (int)blockIdx.x};
        EpiAct E{(h16*)(ws + WS_ACT)};
        pg8::gemm_phase<EpiAct, MoeOrder<2, true>, true, 6>(F.lds, DM, S, E, TSP);
    } SEAM(6); STAMP(7);
    if (IN(7)) {
        load_counts(F);
        MoeOrder<4, false> S{(const LAS int*)(F.MISC + 64), (const char*)(ws + WS_ACT), (const char*)(ws + WS_W2), (const int*)(ws + WS_TOK), (const float*)(ws + WS_WL), F.G, (int)blockIdx.x};
        EpiY E{(h16*)(ws + WS_Y)};
        pg8::gemm_phase<EpiY, MoeOrder<4, false>, false, 7>(F.lds, DEXP, S, E, TSP);
    } SEAM(7); STAMP(8);
    if (IN(8)) { load_counts(F); p8_combine(F); }
#if defined(TS_SEL)
    xcd_barrier(bar); STAMP(9);
#if defined(TS_CONST)
    if (blockIdx.x == TS_BLK && F.tid == TS_TID) F.out[0] = (float)(TS_CONST);
#else
    if (blockIdx.x == TS_BLK && F.tid == TS_TID) F.out[0] = ((float)(F.ts1 - F.ts0) * 0.01f - (float)(TS_OFF)) * 0.2f;
#endif
#endif
#undef IN
#undef SEAM
}

extern "C" void kernel_launch(void* const* d_in, const int* in_sizes, int n_in, void* d_out, int out_size, void* d_ws, size_t ws_size, hipStream_t stream) {
    static int grid = 0;
    if (grid == 0) {
        if (n_in != 17 || in_sizes[0] != NTOK * DM || out_size != NTOK * DM || ws_size < WS_END) {
            fprintf(stderr, "kernel_launch: unexpected problem: n_in %d in0 %d out %d ws %zu; nothing launched\n", n_in, n_in > 0 ? in_sizes[0] : -1, out_size, ws_size); grid = -1; return; }
        int dev = 0, cus = 0, per_cu = 0;
        if (hipGetDevice(&dev) != hipSuccess || hipDeviceGetAttribute(&cus, hipDeviceAttributeMultiprocessorCount, dev) != hipSuccess) { fprintf(stderr, "kernel_launch: device query failed\n"); grid = -1; return; }
        if (hipFuncSetAttribute((const void*)hsb_fwd, hipFuncAttributeMaxDynamicSharedMemorySize, LDS_BYTES) != hipSuccess) { fprintf(stderr, "kernel_launch: hipFuncSetAttribute failed\n"); grid = -1; return; }
        if (hipOccupancyMaxActiveBlocksPerMultiprocessor(&per_cu, (const void*)hsb_fwd, 512, LDS_BYTES) != hipSuccess || per_cu < 1) {
            fprintf(stderr, "kernel_launch: occupancy query reports %d workgroups per CU\n", per_cu); (void)hipGetLastError(); per_cu = 1; }
        grid = cus;
    }
    if (grid < 0) return;
    (void)hipMemsetAsync((char*)d_ws + WS_CTL, 0, CTL_BYTES, stream);
    Args a{};
    for (int i = 0; i < 17; ++i) a.in[i] = (const float*)d_in[i];
    a.out = (float*)d_out; a.ws = (unsigned char*)d_ws;
#if defined(PROBE_DUP_LO)
    const int plan[2][2] = {{0, PROBE_DUP_HI}, {PROBE_DUP_LO, N_PHASES}}; const int nl = 2;
#elif MK_N_LAUNCHES == 1
    const int plan[1][2] = {{0, N_PHASES}}; const int nl = 1;
#else
    int plan[N_PHASES][2]; for (int p = 0; p < N_PHASES; ++p) { plan[p][0] = p; plan[p][1] = p + 1; } const int nl = N_PHASES;
#endif
    for (int l = 0; l < nl; ++l) { a.ph_lo = plan[l][0]; a.ph_hi = plan[l][1]; a.li = l; hipLaunchKernelGGL(hsb_fwd, dim3(grid), dim3(512), LDS_BYTES, stream, a); }
}
```

```cpp
#include <hip/hip_runtime.h>
#include <cstdio>
#include <cstdint>

#define LAS __attribute__((address_space(3)))
#define GAS __attribute__((address_space(1)))
typedef _Float16 h16;
typedef h16 h16x8 __attribute__((ext_vector_type(8)));
typedef h16 h16x4 __attribute__((ext_vector_type(4)));
typedef h16 h16x2 __attribute__((ext_vector_type(2)));
typedef float f32x2 __attribute__((ext_vector_type(2)));
typedef float f32x4 __attribute__((ext_vector_type(4)));
typedef float f32x16 __attribute__((ext_vector_type(16)));
typedef unsigned u32x2 __attribute__((ext_vector_type(2)));
typedef unsigned u32x4 __attribute__((ext_vector_type(4)));
typedef int i32x4 __attribute__((ext_vector_type(4)));

#ifndef MK_N_LAUNCHES
#define MK_N_LAUNCHES 1
#endif
constexpr int N_PHASES = 10;

constexpr int NTOK = 16384, SEQ = 4096, DM = 1024, NH = 8, HD = 64, AW = 512, NPROJ = 5120, NEXP = 32, DEXP = 256;
constexpr float EPS = 1e-6f;
constexpr int LCAP = 16384;
constexpr size_t MiB = 1u << 20;
constexpr size_t WS_CTL = 0, CTL_BYTES = 256 * 1024;
constexpr size_t WS_RW = 512 * 1024;
constexpr size_t WS_WIN = 1 * MiB, WS_WSB = 11 * MiB, WS_WCV = 12 * MiB, WS_WOUT = 13 * MiB, WS_W1 = 15 * MiB, WS_W2 = 47 * MiB;
constexpr size_t WS_H = 63 * MiB;
constexpr size_t WS_Q = 95 * MiB, WS_K = 111 * MiB, WS_VT = 127 * MiB, WS_CB = 143 * MiB, WS_CC = 159 * MiB, WS_CU = 175 * MiB, WS_GA = 191 * MiB, WS_GB = 223 * MiB;
constexpr size_t WS_AO = WS_H, WS_CO = WS_H + 16 * MiB;
constexpr size_t WS_MRG = WS_Q;
constexpr size_t WS_ACT = WS_Q;
constexpr size_t WS_Y = WS_VT;
constexpr size_t WS_X1 = 207 * MiB;
constexpr size_t WS_TOK = 240 * MiB, WS_WL = 242 * MiB, WS_ROUTE = 244 * MiB;
constexpr size_t WS_END = 256 * MiB;
constexpr int CW_CNT = 64;
constexpr int CW_BAR = 8192;

constexpr int RING_BYTES = 131072;
constexpr int SCR_BYTES = 147456;
constexpr int MISC_OFF = SCR_BYTES;
constexpr int LDS_BYTES = SCR_BYTES + 1024;

#define LDS_WAIT() asm volatile("s_waitcnt lgkmcnt(0)" ::: "memory")
#define VM_WAIT() asm volatile("s_waitcnt vmcnt(0)" ::: "memory")

__device__ __forceinline__ unsigned pkh(float lo, float hi) { f32x2 v = {lo, hi}; h16x2 b = __builtin_convertvector(v, h16x2); return __builtin_bit_cast(unsigned, b); }
__device__ __forceinline__ float wave_sum(float v) {
#pragma unroll
    for (int o = 1; o < 64; o <<= 1) v += __shfl_xor(v, o);
    return v;
}
template <int CTRL, int ROWMASK> __device__ __forceinline__ float dpp_mov(float v) { return __builtin_bit_cast(float, __builtin_amdgcn_update_dpp(0, __builtin_bit_cast(int, v), CTRL, ROWMASK, 0xf, false)); }
__device__ __forceinline__ float row_sum16(float v) {
    v += dpp_mov<0xB1, 0xf>(v); v += dpp_mov<0x4E, 0xf>(v); v += dpp_mov<0x141, 0xf>(v); v += dpp_mov<0x140, 0xf>(v); return v;
}
__device__ __forceinline__ float wave_total(float v) {
    v = row_sum16(v);
    v += dpp_mov<0x142, 0xa>(v);
    v += dpp_mov<0x143, 0xc>(v);
    return __builtin_bit_cast(float, __builtin_amdgcn_readlane(__builtin_bit_cast(int, v), 63));
}
__device__ __forceinline__ float sigmoidf_(float x) { return __builtin_amdgcn_rcpf(1.0f + __expf(-x)); }

namespace pg8 {
constexpr int BM = 256, BK = 64, HALF = 128, HTB = HALF * BK * 2, NXCD = 8, WGM = 8;
__device__ __forceinline__ int lds_byte(int r, int c) { const int st = (r >> 4) * 2 + (c >> 5), rr = r & 15, cc = c & 31, ob = rr * 64 + cc * 2; return st * 1024 + (ob ^ (((ob >> 9) & 1) << 5)); }
__device__ __forceinline__ void stage_rc(int b, int& R, int& C) { const int st = b / 1024, sb = b % 1024, swz = sb ^ (((sb >> 9) & 1) << 5); R = (st >> 1) * 16 + swz / 64; C = (st & 1) * 32 + (swz % 64) / 2; }
__device__ __forceinline__ int perm32(int rho) { const int n = rho >> 4, i = rho & 15; return 8 * (i >> 2) + 4 * n + (i & 3); }

struct Unit { const char* a; const char* b; const int* lst; const float* wl; int pm, pn, e, nrows; };

__device__ __forceinline__ void tile_of(int L, int nM, int nN, int& pm, int& pn) {
    const int nwg = nM * nN; int wgid = L; { const int q = nwg / NXCD, r = nwg % NXCD, xcd = wgid % NXCD, off = wgid / NXCD; wgid = (xcd < r ? xcd * (q + 1) : r * (q + 1) + (xcd - r) * q) + off; }
    const int nig = WGM * nN, gid = wgid / nig, fm = gid * WGM, gsz = (nM - fm) < WGM ? (nM - fm) : WGM;
    pm = fm + ((wgid % nig) % gsz); pn = (wgid % nig) / gsz;
}

#if defined(TS_SEL)
#ifndef TS_PH
#define TS_PH -1
#endif
#define GSTAMP(k) do { if (PH == TS_PH) { if ((k) == TS_SEL) tsp[0] = __builtin_amdgcn_s_memrealtime(); if ((k) == TS_END) tsp[1] = __builtin_amdgcn_s_memrealtime(); } } while (0)
#else
#define GSTAMP(k) do { } while (0)
#endif
template <class Epi, class Sched, bool GATHER, int PH = 0>
__device__ __forceinline__ void gemm_phase(LAS unsigned char* lds, const int K, const Sched& S, const Epi& E, unsigned long long* tsp = nullptr) {
    GSTAMP(40);
    const int tid = threadIdx.x, wid = __builtin_amdgcn_readfirstlane(tid >> 6), lane = tid & 63, wr = wid >> 2, wc = wid & 3, fr = lane & 15, fq = lane >> 4;
    const int nt = K / BK;
    unsigned voffA[2], voffB[2]; int RA[2], CA[2];
#pragma unroll
    for (int i = 0; i < 2; ++i) { int R, C; stage_rc(tid * 16 + i * 8192, R, C); const int Rb = Epi::PERM ? ((R & ~31) + perm32(R & 31)) : R;
        RA[i] = R; CA[i] = C; voffA[i] = (unsigned)(R * K + C) * 2u; voffB[i] = (unsigned)(Rb * K + C) * 2u; }
    const size_t kstep = (size_t)(BK * 2);
    const size_t hstep = (size_t)HALF * K * 2;
    const unsigned ldsw = (unsigned)wid * 1024u;
    const int aoff = lds_byte(wr * 64 + fr, fq * 8), boff = lds_byte(wc * 32 + fr, fq * 8);
#define PG8_SA(b, h) (((b) * 2 + (h)) * HTB)
#define PG8_SB(b, h) ((4 + (b) * 2 + (h)) * HTB)
#define PG8_GLDS(bufoff, gptr, i) __builtin_amdgcn_global_load_lds((const unsigned*)(gptr), (LAS unsigned*)(lds + (bufoff) + ldsw + (i) * 8192), 16, 0, 0)
#define PG8_STAGE_B(bufoff, gbase, h) do { PG8_GLDS(bufoff, (const char*)(gbase) + (h) * hstep + voffB[0], 0); PG8_GLDS(bufoff, (const char*)(gbase) + (h) * hstep + voffB[1], 1); } while (0)
#define PG8_STAGE_A(bufoff, gbase, h, v0, v1) do { if constexpr (GATHER) { PG8_GLDS(bufoff, (const char*)(gbase) + (v0), 0); PG8_GLDS(bufoff, (const char*)(gbase) + (v1), 1); } \
        else { PG8_GLDS(bufoff, (const char*)(gbase) + (h) * hstep + voffA[0], 0); PG8_GLDS(bufoff, (const char*)(gbase) + (h) * hstep + voffA[1], 1); } } while (0)
#define PG8_LDA(dst, b, h) do { _Pragma("unroll") for (int m = 0; m < 4; ++m) _Pragma("unroll") for (int k = 0; k < 2; ++k) dst[m][k] = *(const LAS h16x8*)(lds + PG8_SA(b, h) + aoff + m * 2048 + k * 1024); } while (0)
#define PG8_LDB(dst, b, h) do { _Pragma("unroll") for (int n = 0; n < 2; ++n) _Pragma("unroll") for (int k = 0; k < 2; ++k) dst[n][k] = *(const LAS h16x8*)(lds + PG8_SB(b, h) + boff + n * 2048 + k * 1024); } while (0)
#define PG8_MMA(ai, bj, At, Bt) do { __builtin_amdgcn_s_setprio(1); _Pragma("unroll") for (int m = 0; m < 4; ++m) _Pragma("unroll") for (int n = 0; n < 2; ++n) _Pragma("unroll") for (int k = 0; k < 2; ++k) \
        acc[ai][bj][m][n] = __builtin_amdgcn_mfma_f32_16x16x32_f16(Bt[n][k], At[m][k], acc[ai][bj][m][n], 0, 0, 0); __builtin_amdgcn_s_setprio(0); } while (0)
#define PG8_WAIT_V(n) asm volatile("s_waitcnt vmcnt(" #n ")" ::: "memory")
#define PG8_WAIT_L(n) asm volatile("s_waitcnt lgkmcnt(" #n ")" ::: "memory")
#define PG8_BAR __builtin_amdgcn_s_barrier()
#define PG8_SCHED __builtin_amdgcn_sched_barrier(0)
    Unit cur, nxt; int ui = 0;
    if (!S.next(0, cur)) return;
    f32x4 acc[2][2][4][2];
#pragma unroll
    for (int a = 0; a < 2; ++a)
#pragma unroll
        for (int b = 0; b < 2; ++b)
#pragma unroll
            for (int m = 0; m < 4; ++m)
#pragma unroll
                for (int n = 0; n < 2; ++n) acc[a][b][m][n] = (f32x4){0.f, 0.f, 0.f, 0.f};
    h16x8 At[4][2], B0[2][2], B1[2][2];
    const char* cA = cur.a; const char* cB = cur.b;
    unsigned gc00 = 0, gc01 = 0, gc10 = 0, gc11 = 0, gn00 = 0, gn01 = 0, gn10 = 0, gn11 = 0;
#define PG8_GOFF(u, h, i) ((unsigned)(S.tok(u, (h) * HALF + RA[i]) * K + CA[i]) * 2u)
    if constexpr (GATHER) { gc00 = PG8_GOFF(cur, 0, 0); gc01 = PG8_GOFF(cur, 0, 1); gc10 = PG8_GOFF(cur, 1, 0); gc11 = PG8_GOFF(cur, 1, 1); }
    PG8_STAGE_B(PG8_SB(0, 0), cB, 0); PG8_STAGE_B(PG8_SB(0, 1), cB, 1); PG8_STAGE_A(PG8_SA(0, 0), cA, 0, gc00, gc01); PG8_STAGE_A(PG8_SA(0, 1), cA, 1, gc10, gc11);
    if (wr == 1) PG8_BAR;
    PG8_WAIT_V(2); PG8_BAR;
    PG8_STAGE_B(PG8_SB(1, 0), cB + kstep, 0); PG8_STAGE_A(PG8_SA(1, 0), cA + kstep, 0, gc00, gc01); PG8_STAGE_B(PG8_SB(1, 1), cB + kstep, 1);
    PG8_WAIT_V(6); PG8_BAR;
    GSTAMP(41);
    for (;;) {
        const bool has_next = S.next(ui + 1, nxt);
        const char* nA = has_next ? nxt.a : cA; const char* nB = has_next ? nxt.b : cB;
        if constexpr (GATHER) { if (has_next) { gn00 = PG8_GOFF(nxt, 0, 0); gn01 = PG8_GOFF(nxt, 0, 1); gn10 = PG8_GOFF(nxt, 1, 0); gn11 = PG8_GOFF(nxt, 1, 1); } else { gn00 = gc00; gn01 = gc01; gn10 = gc10; gn11 = gc11; } }
#pragma unroll 1
        for (int t = 0; t < nt; t += 2) {
            const bool last = (t == nt - 2);
            const char* a1 = cA + (size_t)(t + 1) * kstep;
            const char* a2 = last ? nA : cA + (size_t)(t + 2) * kstep; const char* b2 = last ? nB : cB + (size_t)(t + 2) * kstep;
            const char* a3 = a2 + kstep; const char* b3 = b2 + kstep;
            unsigned s00 = gc00, s01 = gc01, s10 = gc10, s11 = gc11;
            if constexpr (GATHER) { if (last) { s00 = gn00; s01 = gn01; s10 = gn10; s11 = gn11; } }
            PG8_LDB(B0, 0, 0); PG8_LDB(B1, 0, 1); PG8_SCHED; PG8_LDA(At, 0, 0); PG8_STAGE_A(PG8_SA(1, 1), a1, 1, gc10, gc11);
            PG8_WAIT_V(8); PG8_WAIT_L(0); PG8_BAR; PG8_MMA(0, 0, At, B0); PG8_MMA(0, 1, At, B1); PG8_BAR; PG8_SCHED;
            PG8_LDA(At, 0, 1); PG8_STAGE_B(PG8_SB(0, 0), b2, 0); PG8_STAGE_B(PG8_SB(0, 1), b2, 1); PG8_STAGE_A(PG8_SA(0, 0), a2, 0, s00, s01);
            PG8_WAIT_V(8); PG8_WAIT_L(0); PG8_BAR; PG8_MMA(1, 0, At, B0); PG8_MMA(1, 1, At, B1); PG8_BAR; PG8_SCHED;
            PG8_LDB(B0, 1, 0); PG8_LDB(B1, 1, 1); PG8_SCHED; PG8_LDA(At, 1, 0); PG8_STAGE_A(PG8_SA(0, 1), a2, 1, s10, s11);
            PG8_WAIT_V(8); PG8_WAIT_L(0); PG8_BAR; PG8_MMA(0, 0, At, B0); PG8_MMA(0, 1, At, B1); PG8_BAR; PG8_SCHED;
            PG8_LDA(At, 1, 1); PG8_STAGE_B(PG8_SB(1, 0), b3, 0); PG8_STAGE_B(PG8_SB(1, 1), b3, 1); PG8_STAGE_A(PG8_SA(1, 0), a3, 0, s00, s01);
            PG8_WAIT_V(8); PG8_WAIT_L(0); PG8_BAR; PG8_MMA(1, 0, At, B0); PG8_MMA(1, 1, At, B1); PG8_BAR; PG8_SCHED;
        }
        if (wr == 0) PG8_BAR;
        GSTAMP(42);
        E(acc, cur, wr, wc, fr, fq);
        GSTAMP(43);
        if (!has_next) break;
#pragma unroll
        for (int a = 0; a < 2; ++a)
#pragma unroll
            for (int b = 0; b < 2; ++b)
#pragma unroll
                for (int m = 0; m < 4; ++m)
#pragma unroll
                    for (int n = 0; n < 2; ++n) acc[a][b][m][n] = (f32x4){0.f, 0.f, 0.f, 0.f};
        cur = nxt; cA = nA; cB = nB; ++ui;
        if constexpr (GATHER) { gc00 = gn00; gc01 = gn01; gc10 = gn10; gc11 = gn11; }
        if (wr == 1) PG8_BAR;
    }
    PG8_WAIT_V(0);
    PG8_BAR;
    GSTAMP(44);
#undef PG8_SA
#undef PG8_SB
#undef PG8_GLDS
#undef PG8_STAGE_A
#undef PG8_STAGE_B
#undef PG8_LDA
#undef PG8_LDB
#undef PG8_MMA
#undef PG8_WAIT_V
#undef PG8_WAIT_L
#undef PG8_BAR
#undef PG8_SCHED
#undef PG8_GOFF
}
}
using pg8::Unit;

#define XB_TMO      128
#define XB_XCNT(j)  (256  + 64 * (j))
#define XB_XSUB(j)  (1280 + 64 * (j))
#define XB_XGEN(j)  (2304 + 64 * (j))
#define XB_TOP      3328
#define XB_TOPGEN   3392
#define XCD_BAR_WORDS 3456
#define XB_SPIN_CAP (1u << 20)
__device__ __forceinline__ unsigned xb_ld(unsigned* p)              { return __hip_atomic_load(p, __ATOMIC_RELAXED, __HIP_MEMORY_SCOPE_AGENT); }
__device__ __forceinline__ unsigned xb_add(unsigned* p, unsigned v) { return __hip_atomic_fetch_add(p, v, __ATOMIC_RELAXED, __HIP_MEMORY_SCOPE_AGENT); }
__device__ __forceinline__ unsigned xb_xcc_id() { return (unsigned)__builtin_amdgcn_s_getreg((3 << 11) | 20) & 0xFu; }
#define XB_SPIN(cond, bar) do { unsigned _sp = 0; while (cond) { __builtin_amdgcn_s_sleep(1); \
    if ((++_sp & 255u) == 0u) { if (xb_ld(&(bar)[XB_TMO])) break; if (_sp > XB_SPIN_CAP) { atomicAdd(&(bar)[XB_TMO], 1u); break; } } } } while (0)
struct XcdBarrier { unsigned* bar; unsigned x; volatile LAS unsigned* st; };
__device__ __forceinline__ XcdBarrier xcd_barrier_post(unsigned* bar, volatile LAS unsigned* st) {
    XcdBarrier b; b.bar = bar; b.x = xb_xcc_id(); b.st = st;
    if (threadIdx.x == 0) (void)xb_add(&bar[XB_XCNT(b.x)], 1u);
    return b;
}
__device__ __forceinline__ void xcd_barrier_complete(unsigned* bar, unsigned x, unsigned& nloc, unsigned& nx) {
    const unsigned G = gridDim.x * gridDim.y * gridDim.z;
    unsigned sum, cnt, mine, sp = 0u;
    for (;;) {
        sum = 0u; cnt = 0u; mine = 0u;
#pragma unroll
        for (unsigned j = 0; j < 16; ++j) { const unsigned c = xb_ld(&bar[XB_XCNT(j)]); sum += c; cnt += (c > 0u) ? 1u : 0u; mine = (j == x) ? c : mine; }
        if (sum == G) break;
        __builtin_amdgcn_s_sleep(1);
        if ((++sp & 255u) == 0u) { if (xb_ld(&bar[XB_TMO])) break; if (sp > XB_SPIN_CAP) { atomicAdd(&bar[XB_TMO], 1u); break; } }
    }
    nloc = mine > 0u ? mine : 1u; nx = cnt > 0u ? cnt : 1u;
}
__device__ __forceinline__ void xcd_barrier(const XcdBarrier& b) {
    asm volatile("s_waitcnt vmcnt(0)" ::: "memory");
    __syncthreads();
    if (threadIdx.x == 0) {
        unsigned* bar = b.bar;
        __builtin_amdgcn_s_waitcnt(0);
        unsigned nloc = b.st[0], nx = b.st[1];
        if (nloc == 0u) { xcd_barrier_complete(bar, b.x, nloc, nx); b.st[0] = nloc; b.st[1] = nx; }
        const unsigned old = xb_add(&bar[XB_XSUB(b.x)], 1u);
        const unsigned gen = old / nloc;
        if (old + 1u == (gen + 1u) * nloc) {
            __builtin_amdgcn_fence(__ATOMIC_RELEASE, "agent");
            asm volatile("s_waitcnt vmcnt(0)" ::: "memory");
            const unsigned og = xb_add(&bar[XB_TOP], 1u);
            const unsigned tg = og / nx;
            if (og + 1u == (tg + 1u) * nx) xb_add(&bar[XB_TOPGEN], 1u);
            else XB_SPIN(xb_ld(&bar[XB_TOPGEN]) == tg, bar);
            __builtin_amdgcn_fence(__ATOMIC_ACQUIRE, "agent");
            xb_add(&bar[XB_XGEN(b.x)], 1u);
            asm volatile("s_waitcnt vmcnt(0)" ::: "memory");
        } else {
            XB_SPIN(xb_ld(&bar[XB_XGEN(b.x)]) == gen, bar);
            __builtin_amdgcn_fence(__ATOMIC_ACQUIRE, "agent");
            asm volatile("s_waitcnt vmcnt(0)" ::: "memory");
        }
    }
    __syncthreads();
}

#if defined(TS_SEL)
#ifndef TS_END
#define TS_END (TS_SEL + 1)
#endif
#ifndef TS_TID
#define TS_TID 0
#endif
#ifndef TS_BLK
#define TS_BLK 0
#endif
#ifndef TS_PH
#define TS_PH -1
#endif
#define STAMP(k) do { if ((k) == TS_SEL) F.ts0 = __builtin_amdgcn_s_memrealtime(); if ((k) == TS_END) F.ts1 = __builtin_amdgcn_s_memrealtime(); } while (0)
#else
#define STAMP(k) do { } while (0)
#endif
struct Args { const float* in[17]; float* out; unsigned char* ws; int ph_lo, ph_hi, li, pad; };
struct Frame {
    LAS unsigned char* lds; volatile LAS unsigned* MISC; unsigned* ctl;
    int tid, lane, wave, vcu, G; unsigned* cnt;
#if defined(TS_SEL)
    unsigned long long ts0, ts1;
#endif
    const float* in[17]; float* out; unsigned char* ws;
};

__device__ __forceinline__ void p0_transpose_item(const float* W, int ldw, h16* WT, int K, int k0, int n0, int drow0, LAS float* scr, int lane) {
    float tv[32];
#pragma unroll
    for (int i = 0; i < 32; ++i) tv[i] = W[(size_t)(k0 + 2 * i + (lane >> 5)) * ldw + n0 + (lane & 31)];
#pragma unroll
    for (int i = 0; i < 32; ++i) scr[(2 * i + (lane >> 5)) * 33 + (lane & 31)] = tv[i];
    LDS_WAIT(); asm volatile("" ::: "memory");
    const int c = lane & 7;
#pragma unroll
    for (int j = 0; j < 4; ++j) { const int n = (lane >> 3) + 8 * j; const LAS float* s = scr + (8 * c) * 33 + n;
        u32x4 o; o.x = pkh(s[0 * 33], s[1 * 33]); o.y = pkh(s[2 * 33], s[3 * 33]); o.z = pkh(s[4 * 33], s[5 * 33]); o.w = pkh(s[6 * 33], s[7 * 33]);
        *(u32x4*)(WT + (size_t)(drow0 + n) * K + k0 + 8 * c) = o; }
    LDS_WAIT(); asm volatile("" ::: "memory");
}
__device__ __forceinline__ void p0_prologue(Frame& F) {
    LAS float* scr = (LAS float*)(F.lds + F.wave * 16384);
    const int gw = F.vcu * 8 + F.wave, NGW = F.G * 8, lane = F.lane;
    unsigned char* ws = F.ws;
    constexpr int I_IN = 16 * 160, I_SB = 8 * 32, I_CV = 8 * 32, I_OUT = 16 * 32, I_G = 32 * 16 * 8, I_U = I_G, I_D = 32 * 4 * 32;
    constexpr int NITEMS = I_IN + I_SB + I_CV + I_OUT;
    for (int it = gw; it < NITEMS; it += NGW) {
        int r = it;
        if (r < I_IN) { const int kb = r / 160, nb = r % 160, n0 = nb * 32; int drow = n0;
            if (n0 < 1536) { const int tile = n0 >> 8, within = n0 & 255, wc = within >> 6, bj = (within >> 5) & 1; drow = tile * 256 + 128 * bj + 32 * wc; }
            p0_transpose_item(F.in[2], NPROJ, (h16*)(ws + WS_WIN), DM, kb * 64, n0, drow, scr, lane); continue; } r -= I_IN;
        if (r < I_SB) { const int kb = r / 32, nb = r % 32; p0_transpose_item(F.in[6], DM, (h16*)(ws + WS_WSB), AW, kb * 64, nb * 32, nb * 32, scr, lane); continue; } r -= I_SB;
        if (r < I_CV) { const int kb = r / 32, nb = r % 32; p0_transpose_item(F.in[7], DM, (h16*)(ws + WS_WCV), AW, kb * 64, nb * 32, nb * 32, scr, lane); continue; } r -= I_CV;
        { const int kb = r / 32, nb = r % 32; p0_transpose_item(F.in[8], DM, (h16*)(ws + WS_WOUT), DM, kb * 64, nb * 32, nb * 32, scr, lane); }
    }
    { float* RW = (float*)(ws + WS_RW); const float* g2 = F.in[9]; const float* wg = F.in[10]; const float* we = F.in[12];
      for (int i = (F.vcu * 8 + F.wave) * 64 + lane; i < 36 * 1024; i += F.G * 512) { const int c = i >> 10, k = i & 1023; RW[i] = g2[k] * (c < 4 ? wg[k * 4 + c] : we[k * 32 + (c - 4)]); } }
    { const float* g1 = F.in[1]; h16* H = (h16*)(ws + WS_H);
      f32x4 gv[4];
#pragma unroll
      for (int j = 0; j < 4; ++j) gv[j] = ((const f32x4*)g1)[lane + 64 * j];
      for (int m0 = gw; m0 < NTOK; m0 += 4 * NGW) {
        f32x4 v[4][4];
#pragma unroll
        for (int i = 0; i < 4; ++i) { const int m = m0 + i * NGW; const f32x4* xr = (const f32x4*)(F.in[0] + (size_t)(m < NTOK ? m : m0) * DM) + lane;
#pragma unroll
            for (int j = 0; j < 4; ++j) v[i][j] = xr[64 * j]; }
#pragma unroll
        for (int i = 0; i < 4; ++i) { const int m = m0 + i * NGW; if (m < NTOK) { float s = 0.f;
#pragma unroll
            for (int j = 0; j < 4; ++j) s += (v[i][j].x * v[i][j].x + v[i][j].y * v[i][j].y) + (v[i][j].z * v[i][j].z + v[i][j].w * v[i][j].w);
            const float rstd = rsqrtf(wave_total(s) * (1.f / DM) + EPS);
            u32x2* o8 = (u32x2*)(H + (size_t)m * DM) + lane;
#pragma unroll
            for (int j = 0; j < 4; ++j) { const f32x4 y = v[i][j] * rstd * gv[j]; u32x2 w; w.x = pkh(y.x, y.y); w.y = pkh(y.z, y.w); o8[64 * j] = w; } } }
      } }
}

struct XItem { const float* src; h16* dst; int ldw, K; };
__device__ __forceinline__ XItem expert_item(const Frame& F, int it) {
    constexpr int I_G = 32 * 16 * 8; XItem x; int r = it;
    if (r < 2 * I_G) { const int up = r >= I_G; if (up) r -= I_G; const int e = r / 128, q = r % 128, kb = q / 8, nb = q % 8, n0 = nb * 32;
        const int drow = 256 * (n0 >> 7) + 128 * up + (n0 & 127);
        x.src = F.in[up ? 15 : 14] + (size_t)e * DM * DEXP + (size_t)(kb * 64) * DEXP + n0; x.ldw = DEXP; x.K = DM;
        x.dst = (h16*)(F.ws + WS_W1) + ((size_t)e * 512 + drow) * DM + kb * 64; }
    else { r -= 2 * I_G; const int e = r / 128, q = r % 128, kb = q / 32, nb = q % 32;
        x.src = F.in[16] + (size_t)e * DEXP * DM + (size_t)(kb * 64) * DM + nb * 32; x.ldw = DM; x.K = DEXP;
        x.dst = (h16*)(F.ws + WS_W2) + ((size_t)e * DM + nb * 32) * DEXP + kb * 64; }
    return x;
}
__device__ __forceinline__ void convert_experts(Frame& F) {
    LAS float* scr = (LAS float*)(F.lds + F.wave * 16384);
    const int gw = F.vcu * 8 + F.wave, NGW = F.G * 8, lane = F.lane;
    constexpr int NIT = 2 * 32 * 16 * 8 + 32 * 4 * 32;
    if (gw >= NIT) return;
    XItem cur = expert_item(F, gw);
    float tv[32];
#pragma unroll
    for (int i = 0; i < 32; ++i) tv[i] = cur.src[(size_t)(2 * i + (lane >> 5)) * cur.ldw + (lane & 31)];
    for (int it = gw; it < NIT; it += NGW) {
        const int nx = it + NGW; const bool hn = nx < NIT;
        XItem nxt = cur; float tn[32];
        if (hn) { nxt = expert_item(F, nx);
#pragma unroll
            for (int i = 0; i < 32; ++i) tn[i] = nxt.src[(size_t)(2 * i + (lane >> 5)) * nxt.ldw + (lane & 31)]; }
#pragma unroll
        for (int i = 0; i < 32; ++i) scr[(2 * i + (lane >> 5)) * 33 + (lane & 31)] = tv[i];
        LDS_WAIT(); asm volatile("" ::: "memory");
        const int c = lane & 7;
#pragma unroll
        for (int j = 0; j < 4; ++j) { const int n = (lane >> 3) + 8 * j; const LAS float* p = scr + (8 * c) * 33 + n;
            u32x4 o; o.x = pkh(p[0 * 33], p[1 * 33]); o.y = pkh(p[2 * 33], p[3 * 33]); o.z = pkh(p[4 * 33], p[5 * 33]); o.w = pkh(p[6 * 33], p[7 * 33]);
            *(u32x4*)(cur.dst + (size_t)n * cur.K + 8 * c) = o; }
        LDS_WAIT(); asm volatile("" ::: "memory");
        if (hn) {
#pragma unroll
            for (int i = 0; i < 32; ++i) tv[i] = tn[i]; }
        cur = nxt;
    }
}

struct StaticOrder {
    const char* A; const char* Bt; int nM, nN, G, c; size_t tstep;
    __device__ __forceinline__ bool next(int i, Unit& u) const {
        const int L = i * G + c; if (L >= nM * nN) return false;
        int pm, pn; pg8::tile_of(L, nM, nN, pm, pn); u.pm = pm; u.pn = pn; u.e = 0; u.nrows = 256; u.lst = nullptr; u.wl = nullptr;
        u.a = A + (size_t)pm * tstep; u.b = Bt + (size_t)pn * tstep; return true;
    }
    __device__ __forceinline__ int tok(const Unit&, int) const { return 0; }
};
struct BranchOrder {
    const char* Aa; const char* Ab; const char* Ba; const char* Bb; int G, c;
    __device__ __forceinline__ bool next(int i, Unit& u) const {
        const int L = (i >> 1) * G + c; if (L >= 64 * 4) return false;
        int pm, pn; pg8::tile_of(L, 64, 4, pm, pn); u.pm = pm; u.pn = pn; u.e = i & 1; u.nrows = 256; u.lst = nullptr; u.wl = nullptr;
        const size_t tstep = (size_t)256 * AW * 2;
        u.a = ((i & 1) ? Ab : Aa) + (size_t)pm * tstep; u.b = ((i & 1) ? Bb : Ba) + (size_t)pn * tstep; return true;
    }
    __device__ __forceinline__ int tok(const Unit&, int) const { return 0; }
};
template <int NN, bool G1> struct MoeOrder {
    const LAS int* cntl; const char* A; const char* Bt; const int* tok_list; const float* w_list; int G, c, lo, hi;
    __device__ __forceinline__ bool next(int i, Unit& u) const {
        const int L = lo + i * G + c; if (L >= hi || c < 0) return false;
        const int mtg = L / NN, pn = L % NN;
        int acc = 0, e = -1, mtl = 0, ce = 0;
        for (int j = 0; j < NEXP; ++j) { const int cj = cntl[j], t = (cj + 255) >> 8; if (e < 0 && mtg < acc + t) { e = j; mtl = mtg - acc; ce = cj; } acc += t; }
        if (e < 0) return false;
        e = __builtin_amdgcn_readfirstlane(e); mtl = __builtin_amdgcn_readfirstlane(mtl); ce = __builtin_amdgcn_readfirstlane(ce);
        u.pm = mtg; u.pn = pn; u.e = e; const int nr = ce - mtl * 256; u.nrows = nr < 256 ? nr : 256;
        u.lst = tok_list + (size_t)e * LCAP + mtl * 256; u.wl = w_list + (size_t)e * LCAP + mtl * 256;
        if (G1) { u.a = A; u.b = Bt + ((size_t)e * 512 + pn * 256) * DM * 2; }
        else { u.a = A + (size_t)mtg * 256 * DEXP * 2; u.b = Bt + ((size_t)e * DM + pn * 256) * DEXP * 2; }
        return true;
    }
    __device__ __forceinline__ int tok(const Unit& u, int r) const { return r < u.nrows ? u.lst[r] : 0; }
};

__device__ __forceinline__ u32x4 pack8(const f32x4 a, const f32x4 b) { u32x4 w; w.x = pkh(a[0], a[1]); w.y = pkh(a[2], a[3]); w.z = pkh(b[0], b[1]); w.w = pkh(b[2], b[3]); return w; }
__device__ __forceinline__ void unpack8(const u32x4 w, f32x4& a, f32x4& b) {
    const h16x8 h = __builtin_bit_cast(h16x8, w);
    a = (f32x4){(float)h[0], (float)h[1], (float)h[2], (float)h[3]}; b = (f32x4){(float)h[4], (float)h[5], (float)h[6], (float)h[7]};
}
struct EpiProj {
    static constexpr bool PERM = true;
    unsigned char* ws; const float* qg; const float* kg;
    __device__ __forceinline__ void operator()(const f32x4 (&acc)[2][2][4][2], const Unit& u, int wr, int wc, int fr, int fq) const {
        const int row0 = u.pm * 256 + wr * 64 + fr, pn = u.pn;
        if (pn < 4) {
            const bool isq = pn < 2; const int head = 4 * (pn & 1) + wc; const float* gp = isq ? qg : kg; const float sc = isq ? 0.125f * 1.4426950408889634f : 1.0f;
            h16* dst = (h16*)(ws + (isq ? WS_Q : WS_K));
            const f32x4 g00 = *(const f32x4*)(gp + 8 * fq), g01 = *(const f32x4*)(gp + 8 * fq + 4), g10 = *(const f32x4*)(gp + 32 + 8 * fq), g11 = *(const f32x4*)(gp + 32 + 8 * fq + 4);
#pragma unroll
            for (int ai = 0; ai < 2; ++ai)
#pragma unroll
                for (int m = 0; m < 4; ++m) {
                    const f32x4 a0 = acc[ai][0][m][0], a1 = acc[ai][0][m][1], b0 = acc[ai][1][m][0], b1 = acc[ai][1][m][1];
                    float ss = (a0[0] * a0[0] + a0[1] * a0[1]) + (a0[2] * a0[2] + a0[3] * a0[3]) + (a1[0] * a1[0] + a1[1] * a1[1]) + (a1[2] * a1[2] + a1[3] * a1[3])
                             + (b0[0] * b0[0] + b0[1] * b0[1]) + (b0[2] * b0[2] + b0[3] * b0[3]) + (b1[0] * b1[0] + b1[1] * b1[1]) + (b1[2] * b1[2] + b1[3] * b1[3]);
                    ss += __shfl_xor(ss, 16); ss += __shfl_xor(ss, 32);
                    const float r = rsqrtf(ss * (1.f / HD) + EPS) * sc;
                    h16* rowp = dst + (size_t)(row0 + ai * 128 + m * 16) * AW + head * HD + 8 * fq;
                    __builtin_nontemporal_store(pack8(a0 * r * g00, a1 * r * g01), (u32x4*)(rowp));
                    __builtin_nontemporal_store(pack8(b0 * r * g10, b1 * r * g11), (u32x4*)(rowp + 32));
                }
        } else if (pn < 6) {
            const int head = 4 * (pn & 1) + wc; h16* VT = (h16*)(ws + WS_VT);
            const int pf = fr ^ ((((fr >> 2) ^ (fr >> 3)) & 1) ? 12 : 0);
#pragma unroll
            for (int ai = 0; ai < 2; ++ai)
#pragma unroll
                for (int m = 0; m < 4; ++m) {
                    const int row = row0 + ai * 128 + m * 16, b = row >> 12, s = row & (SEQ - 1);
                    h16* colp = VT + ((size_t)(b * NH + head) * HD + 8 * fq) * SEQ + (s & ~15) + pf;
#pragma unroll
                    for (int bj = 0; bj < 2; ++bj)
#pragma unroll
                        for (int n = 0; n < 2; ++n)
#pragma unroll
                            for (int j = 0; j < 4; ++j) colp[(size_t)(32 * bj + 4 * n + j) * SEQ] = (h16)acc[ai][bj][m][n][j];
                }
        } else {
            const bool gate = pn >= 12; h16* dst; int ldc, col0;
            if (!gate) { const int w = (pn - 6) >> 1; dst = (h16*)(ws + WS_CB + (size_t)w * 16 * MiB); ldc = AW; col0 = ((pn - 6) & 1) * 256; }
            else { const int w = (pn - 12) >> 2; dst = (h16*)(ws + WS_GA + (size_t)w * 32 * MiB); ldc = DM; col0 = ((pn - 12) & 3) * 256; }
            col0 += wc * 32 + 8 * fq;
#pragma unroll
            for (int ai = 0; ai < 2; ++ai)
#pragma unroll
                for (int m = 0; m < 4; ++m) { h16* rowp = dst + (size_t)(row0 + ai * 128 + m * 16) * ldc + col0;
#pragma unroll
                    for (int bj = 0; bj < 2; ++bj) { f32x4 v0 = acc[ai][bj][m][0], v1 = acc[ai][bj][m][1];
                        if (gate) {
#pragma unroll
                            for (int j = 0; j < 4; ++j) { v0[j] = sigmoidf_(v0[j]); v1[j] = sigmoidf_(v1[j]); } }
                        __builtin_nontemporal_store(pack8(v0, v1), (u32x4*)(rowp + bj * 128)); } }
        }
    }
};
struct EpiBranch {
    static constexpr bool PERM = true;
    unsigned char* ws;
    __device__ __forceinline__ void operator()(const f32x4 (&acc)[2][2][4][2], const Unit& u, int wr, int wc, int fr, int fq) const {
        const int row0 = u.pm * 256 + wr * 64 + fr; const int col0 = u.pn * 256 + wc * 32 + 8 * fq; const bool second = u.e != 0;
        const h16* gt = (const h16*)(ws + (second ? WS_GB : WS_GA)); h16* H = (h16*)(ws + WS_MRG);
#pragma unroll
        for (int ai = 0; ai < 2; ++ai) {
            u32x4 gq[4][2], hq[4][2];
#pragma unroll
            for (int m = 0; m < 4; ++m)
#pragma unroll
                for (int bj = 0; bj < 2; ++bj) { const size_t off = (size_t)(row0 + ai * 128 + m * 16) * DM + col0 + bj * 128; gq[m][bj] = *(const u32x4*)(gt + off); if (second) hq[m][bj] = *(const u32x4*)(H + off); }
#pragma unroll
            for (int m = 0; m < 4; ++m)
#pragma unroll
                for (int bj = 0; bj < 2; ++bj) { const size_t off = (size_t)(row0 + ai * 128 + m * 16) * DM + col0 + bj * 128; f32x4 g0, g1; unpack8(gq[m][bj], g0, g1);
                    f32x4 v0 = acc[ai][bj][m][0] * g0, v1 = acc[ai][bj][m][1] * g1;
                    if (second) { f32x4 p0, p1; unpack8(hq[m][bj], p0, p1); v0 += p0; v1 += p1; }
                    *(u32x4*)(H + off) = pack8(v0, v1); } }
    }
};
struct EpiOut {
    static constexpr bool PERM = true;
    const float* x; h16* x1;
    __device__ __forceinline__ void operator()(const f32x4 (&acc)[2][2][4][2], const Unit& u, int wr, int wc, int fr, int fq) const {
        const int row0 = u.pm * 256 + wr * 64 + fr, col0 = u.pn * 256 + wc * 32 + 8 * fq;
#pragma unroll
        for (int ai = 0; ai < 2; ++ai) {
            f32x4 xv[4][2][2];
#pragma unroll
            for (int m = 0; m < 4; ++m)
#pragma unroll
                for (int bj = 0; bj < 2; ++bj)
#pragma unroll
                    for (int n = 0; n < 2; ++n) xv[m][bj][n] = *(const f32x4*)(x + (size_t)(row0 + ai * 128 + m * 16) * DM + col0 + bj * 128 + n * 4);
#pragma unroll
            for (int m = 0; m < 4; ++m)
#pragma unroll
                for (int bj = 0; bj < 2; ++bj) *(u32x4*)(x1 + (size_t)(row0 + ai * 128 + m * 16) * DM + col0 + bj * 128) = pack8(xv[m][bj][0] + acc[ai][bj][m][0], xv[m][bj][1] + acc[ai][bj][m][1]); }
    }
};
struct EpiAct {
    static constexpr bool PERM = true;
    h16* act;
    __device__ __forceinline__ void operator()(const f32x4 (&acc)[2][2][4][2], const Unit& u, int wr, int wc, int fr, int fq) const {
        const int r0 = wr * 64 + fr; const int col0 = u.pn * 128 + wc * 32 + 8 * fq;
        float wv[2][4];
#pragma unroll
        for (int ai = 0; ai < 2; ++ai)
#pragma unroll
            for (int m = 0; m < 4; ++m) { const int r = r0 + ai * 128 + m * 16; wv[ai][m] = r < u.nrows ? u.wl[r] : 0.f; }
#pragma unroll
        for (int ai = 0; ai < 2; ++ai)
#pragma unroll
            for (int m = 0; m < 4; ++m) { const int r = r0 + ai * 128 + m * 16; const float w = wv[ai][m];
                f32x4 v0, v1;
#pragma unroll
                for (int j = 0; j < 4; ++j) { const float g0 = acc[ai][0][m][0][j], g1 = acc[ai][0][m][1][j];
                    v0[j] = g0 * sigmoidf_(g0) * acc[ai][1][m][0][j] * w; v1[j] = g1 * sigmoidf_(g1) * acc[ai][1][m][1][j] * w; }
                *(u32x4*)(act + (size_t)(u.pm * 256 + r) * DEXP + col0) = pack8(v0, v1); }
    }
};
struct EpiY {
    static constexpr bool PERM = true;
    h16* y;
    __device__ __forceinline__ void operator()(const f32x4 (&acc)[2][2][4][2], const Unit& u, int wr, int wc, int fr, int fq) const {
        const int row0 = u.pm * 256 + wr * 64 + fr, col0 = u.pn * 256 + wc * 32 + 8 * fq;
#pragma unroll
        for (int ai = 0; ai < 2; ++ai)
#pragma unroll
            for (int m = 0; m < 4; ++m) { h16* rowp = y + (size_t)(row0 + ai * 128 + m * 16) * DM + col0;
#pragma unroll
                for (int bj = 0; bj < 2; ++bj) *(u32x4*)(rowp + bj * 128) = pack8(acc[ai][bj][m][0], acc[ai][bj][m][1]); }
    }
};

constexpr float SB_EXIT = 25.0f;
__device__ __forceinline__ void attn_stage(LAS unsigned char* st, const h16* kbase, const h16* vbase, int kt) {
#pragma unroll
    for (int s = 0; s < 4; ++s) __builtin_amdgcn_global_load_lds((const unsigned*)(kbase + (size_t)(kt * 32) * AW + 16 * s), (LAS unsigned*)(st + s * 1024), 16, 0, 0);
#pragma unroll
    for (int db = 0; db < 2; ++db)
#pragma unroll
        for (int s2 = 0; s2 < 2; ++s2) __builtin_amdgcn_global_load_lds((const unsigned*)(vbase + (size_t)(32 * db) * SEQ + kt * 32 + 16 * s2), (LAS unsigned*)(st + (4 + 2 * db + s2) * 1024), 16, 0, 0);
}
__device__ __forceinline__ void sb_block(const f32x16& p, float& run, const bool diag, const int r, const int hh, h16x8& bp0, h16x8& bp1) {
    float sp[16];
#pragma unroll
    for (int i = 0; i < 16; ++i) { const float z = p[i]; float v = fmaxf(z, 0.f) + __builtin_amdgcn_logf(1.0f + __builtin_amdgcn_exp2f(-fabsf(z)));
        if (diag) { const int key = (i & 3) + 8 * (i >> 2) + 4 * hh; v = key < r ? v : 0.f; }
        sp[i] = v; }
    float G[4], Go[4], T[4];
#pragma unroll
    for (int g = 0; g < 4; ++g) { G[g] = (sp[4 * g] + sp[4 * g + 1]) + (sp[4 * g + 2] + sp[4 * g + 3]); Go[g] = __shfl_xor(G[g], 32); T[g] = G[g] + Go[g]; }
    float base[4];
    base[3] = run; base[2] = run + T[3]; base[1] = base[2] + T[2]; base[0] = base[1] + T[1];
    float a[16];
#pragma unroll
    for (int g = 0; g < 4; ++g) { float t = base[g] + (hh == 0 ? Go[g] : 0.f);
#pragma unroll
        for (int w = 3; w >= 0; --w) { const int i = 4 * g + w; float e = __builtin_amdgcn_exp2f(p[i] - sp[i] - t);
            if (diag) { const int key = (i & 3) + 8 * (i >> 2) + 4 * hh; e = key < r ? e : 0.f; }
            a[i] = e; t += sp[i]; } }
    run = base[0] + T[0];
#pragma unroll
    for (int j = 0; j < 8; ++j) { bp0[j] = (h16)a[j]; bp1[j] = (h16)a[8 + j]; }
}
__device__ __forceinline__ void attn_task(Frame& F, int b, int h, int m, const h16* Q, const h16* Kb, const h16* VT, h16* AO, LAS unsigned char* stage, int lane) {
    STAMP(30);
    const int r = lane & 31, hh = lane >> 5;
    const size_t tb = (size_t)b * SEQ;
    const h16* kbase = Kb + (tb + r) * AW + h * HD + 8 * hh;
    const h16* vbase = VT + ((size_t)(b * NH + h) * HD + r) * SEQ + 8 * hh;
    const int ktop = 2 * m + 1;
    attn_stage(stage, kbase, vbase, ktop);
    const h16* qrow = Q + (tb + m * 64 + r) * AW + h * HD + 8 * hh;
    h16x8 bqA[4], bqB[4];
#pragma unroll
    for (int s = 0; s < 4; ++s) { bqA[s] = *(const h16x8*)(qrow + 16 * s); bqB[s] = *(const h16x8*)(qrow + (size_t)32 * AW + 16 * s); }
    f32x16 oA0 = {}, oA1 = {}, oB0 = {}, oB1 = {}; float runA = 0.f, runB = 0.f;
    int buf = 0;
    for (int kt = ktop; kt >= 0; --kt) {
        const LAS unsigned char* st = stage + buf * 8192 + lane * 16;
        h16x8 ak[4], av[2][2];
        VM_WAIT(); if (kt == ktop) STAMP(31);
#pragma unroll
        for (int s = 0; s < 4; ++s) ak[s] = *(const LAS h16x8*)(st + s * 1024);
#pragma unroll
        for (int db = 0; db < 2; ++db)
#pragma unroll
            for (int s2 = 0; s2 < 2; ++s2) av[db][s2] = *(const LAS h16x8*)(st + (4 + 2 * db + s2) * 1024);
        buf ^= 1;
        attn_stage(stage + buf * 8192, kbase, vbase, kt > 0 ? kt - 1 : 0);
        const bool actA = kt < ktop;
        f32x16 pB = {}, pA = {};
#pragma unroll
        for (int s = 0; s < 4; ++s) pB = __builtin_amdgcn_mfma_f32_32x32x16_f16(ak[s], bqB[s], pB, 0, 0, 0);
        if (actA) {
#pragma unroll
            for (int s = 0; s < 4; ++s) pA = __builtin_amdgcn_mfma_f32_32x32x16_f16(ak[s], bqA[s], pA, 0, 0, 0); }
        h16x8 bp0, bp1;
        sb_block(pB, runB, kt == ktop, r, hh, bp0, bp1);
        oB0 = __builtin_amdgcn_mfma_f32_32x32x16_f16(av[0][0], bp0, oB0, 0, 0, 0);
        oB0 = __builtin_amdgcn_mfma_f32_32x32x16_f16(av[0][1], bp1, oB0, 0, 0, 0);
        oB1 = __builtin_amdgcn_mfma_f32_32x32x16_f16(av[1][0], bp0, oB1, 0, 0, 0);
        oB1 = __builtin_amdgcn_mfma_f32_32x32x16_f16(av[1][1], bp1, oB1, 0, 0, 0);
        if (actA) {
            sb_block(pA, runA, kt == ktop - 1, r, hh, bp0, bp1);
            oA0 = __builtin_amdgcn_mfma_f32_32x32x16_f16(av[0][0], bp0, oA0, 0, 0, 0);
            oA0 = __builtin_amdgcn_mfma_f32_32x32x16_f16(av[0][1], bp1, oA0, 0, 0, 0);
            oA1 = __builtin_amdgcn_mfma_f32_32x32x16_f16(av[1][0], bp0, oA1, 0, 0, 0);
            oA1 = __builtin_amdgcn_mfma_f32_32x32x16_f16(av[1][1], bp1, oA1, 0, 0, 0);
            if (__all(runA > SB_EXIT && runB > SB_EXIT)) break; }
    }
    STAMP(32);
    VM_WAIT();
    STAMP(33);
    h16* orow = AO + (tb + m * 64 + r) * AW + h * HD + 4 * hh;
#pragma unroll
    for (int g = 0; g < 4; ++g) {
        u32x2 w; w.x = pkh(oA0[4 * g], oA0[4 * g + 1]); w.y = pkh(oA0[4 * g + 2], oA0[4 * g + 3]); *(u32x2*)(orow + 8 * g) = w;
        w.x = pkh(oA1[4 * g], oA1[4 * g + 1]); w.y = pkh(oA1[4 * g + 2], oA1[4 * g + 3]); *(u32x2*)(orow + 32 + 8 * g) = w;
        w.x = pkh(oB0[4 * g], oB0[4 * g + 1]); w.y = pkh(oB0[4 * g + 2], oB0[4 * g + 3]); *(u32x2*)(orow + (size_t)32 * AW + 8 * g) = w;
        w.x = pkh(oB1[4 * g], oB1[4 * g + 1]); w.y = pkh(oB1[4 * g + 2], oB1[4 * g + 3]); *(u32x2*)(orow + (size_t)32 * AW + 32 + 8 * g) = w; }
    STAMP(34);
}
__device__ __forceinline__ void p2_attn_conv(Frame& F) {
    const int gw = F.vcu * 8 + F.wave, NGW = F.G * 8, lane = F.lane;
    const h16* Q = (const h16*)(F.ws + WS_Q); h16* AO = (h16*)(F.ws + WS_AO); const h16* Kb = (const h16*)(F.ws + WS_K); const h16* VT = (const h16*)(F.ws + WS_VT);
    STAMP(20);
    for (int t = gw; t < 32 * 64; t += NGW) { const int bh = t >> 6, j = t & 63, m = (j & 1) ? (63 - (j >> 1)) : (j >> 1);
        attn_task(F, bh >> 3, bh & 7, m, Q, Kb, VT, AO, F.lds + F.wave * 16384, lane); }
    STAMP(21);
    STAMP(22);
    const h16* CB = (const h16*)(F.ws + WS_CB); h16* CO = (h16*)(F.ws + WS_CO); const h16* CC = (const h16*)(F.ws + WS_CC); const h16* CU = (const h16*)(F.ws + WS_CU); const float* cw = F.in[5];
    f32x4 w0a = *(const f32x4*)(cw + 8 * lane), w0b = *(const f32x4*)(cw + 8 * lane + 4), w1a = *(const f32x4*)(cw + AW + 8 * lane), w1b = *(const f32x4*)(cw + AW + 8 * lane + 4),
          w2a = *(const f32x4*)(cw + 2 * AW + 8 * lane), w2b = *(const f32x4*)(cw + 2 * AW + 8 * lane + 4);
    for (int c = gw; c < NTOK / 8; c += NGW) { const int t0 = c * 8; const bool first = (t0 & (SEQ - 1)) == 0;
        u32x4 rc[10], ru[10], rb[8];
#pragma unroll
        for (int i = 0; i < 10; ++i) { const int t = t0 - 2 + i; const size_t off = (size_t)((i < 2 && first) ? t0 : t) * AW + 8 * lane; rc[i] = *(const u32x4*)(CC + off); ru[i] = *(const u32x4*)(CU + off); }
#pragma unroll
        for (int i = 0; i < 8; ++i) rb[i] = *(const u32x4*)(CB + (size_t)(t0 + i) * AW + 8 * lane);
        f32x4 pa2, pb2, pa1, pb1;
        { f32x4 x0, x1, y0, y1; unpack8(rc[0], x0, x1); unpack8(ru[0], y0, y1); pa2 = x0 * y0; pb2 = x1 * y1; unpack8(rc[1], x0, x1); unpack8(ru[1], y0, y1); pa1 = x0 * y0; pb1 = x1 * y1; }
        if (first) { pa2 = (f32x4){0.f, 0.f, 0.f, 0.f}; pb2 = pa2; pa1 = pa2; pb1 = pa2; }
#pragma unroll
        for (int i = 0; i < 8; ++i) { f32x4 x0, x1, y0, y1, b0, b1;
            unpack8(rc[i + 2], x0, x1); unpack8(ru[i + 2], y0, y1); unpack8(rb[i], b0, b1);
            const f32x4 pa0 = x0 * y0, pb0 = x1 * y1;
            const f32x4 ya = b0 * (w0a * pa2 + w1a * pa1 + w2a * pa0), yb = b1 * (w0b * pb2 + w1b * pb1 + w2b * pb0);
            *(u32x4*)(CO + (size_t)(t0 + i) * AW + 8 * lane) = pack8(ya, yb);
            pa2 = pa1; pb2 = pb1; pa1 = pa0; pb1 = pb0; } }
    STAMP(23);
}

__device__ __forceinline__ float reduce4(float s0, float s1, float s2, float s3, const bool b0, const bool b1) {
    const float t0 = (b0 ? s1 : s0) + dpp_mov<0xB1, 0xf>(b0 ? s0 : s1);
    const float t1 = (b0 ? s3 : s2) + dpp_mov<0xB1, 0xf>(b0 ? s2 : s3);
    float u = (b1 ? t1 : t0) + dpp_mov<0x4E, 0xf>(b1 ? t0 : t1);
    u += dpp_mov<0x124, 0xf>(u); u += dpp_mov<0x128, 0xf>(u);
    u += __builtin_bit_cast(float, __builtin_amdgcn_ds_swizzle(__builtin_bit_cast(int, u), 0x401F));
    u += __shfl_xor(u, 32);
    return u;
}
__device__ __forceinline__ float dot16(const f32x4 (&v)[4], const LAS float* w) {
    float a = 0.f;
#pragma unroll
    for (int j = 0; j < 4; ++j) { const f32x4 x = *(const LAS f32x4*)(w + 256 * j); a += (v[j].x * x.x + v[j].y * x.y) + (v[j].z * x.z + v[j].w * x.w); }
    return a;
}
__device__ __forceinline__ void p5_router(Frame& F) {
    const int gw = F.vcu * 8 + F.wave, NGW = F.G * 8, lane = F.lane;
    STAMP(50);
    LAS float* RW = (LAS float*)F.lds;
    { const unsigned char* src = F.ws + WS_RW + lane * 16;
#pragma unroll
      for (int i = 0; i < 18; ++i) __builtin_amdgcn_global_load_lds((const unsigned*)(src + (F.wave * 18 + i) * 1024), (LAS unsigned*)(F.lds + (F.wave * 18 + i) * 1024), 16, 0, 0); }
    LAS unsigned* lcnt = (LAS unsigned*)(F.MISC + 128); LAS unsigned* lbase = (LAS unsigned*)(F.MISC + 160);
    const float* g2 = F.in[9]; const float* bg = F.in[11]; const float* be = F.in[13];
    h16* H = (h16*)(F.ws + WS_H); int* TOK = (int*)(F.ws + WS_TOK); float* WL = (float*)(F.ws + WS_WL); i32x4* ROUTE = (i32x4*)(F.ws + WS_ROUTE);
    const bool b0 = lane & 1, b1 = (lane >> 1) & 1;
    VM_WAIT();
    f32x4 gv[4];
#pragma unroll
    for (int j = 0; j < 4; ++j) gv[j] = ((const f32x4*)g2)[lane + 64 * j];
    const float bgl[4] = {bg[0], bg[1], bg[2], bg[3]};
    for (int base = 0; base < NTOK; base += NGW * 8) {
        if (F.tid < NEXP) lcnt[F.tid] = 0u;
        __syncthreads();
        STAMP(51);
        int ke0 = 0, ke1 = 0, km = -1; float kw0 = 0.f, kw1 = 0.f;
#pragma unroll 1
        for (int ps = 0; ps < 2; ++ps) {
            const int mb = base + gw + (4 * ps) * NGW;
            f32x4 v[4][4];
#pragma unroll
            for (int i = 0; i < 4; ++i) { const int m = mb + i * NGW; const u32x2* xr = (const u32x2*)((const h16*)(F.ws + WS_X1) + (size_t)(m < NTOK ? m : 0) * DM) + lane;
#pragma unroll
                for (int j = 0; j < 4; ++j) { const h16x4 t = __builtin_bit_cast(h16x4, xr[64 * j]); v[i][j] = (f32x4){(float)t[0], (float)t[1], (float)t[2], (float)t[3]}; } }
            float ss[4];
#pragma unroll
            for (int i = 0; i < 4; ++i) { float s = 0.f;
#pragma unroll
                for (int j = 0; j < 4; ++j) s += (v[i][j].x * v[i][j].x + v[i][j].y * v[i][j].y) + (v[i][j].z * v[i][j].z + v[i][j].w * v[i][j].w);
                ss[i] = s; }
            const float rstd = rsqrtf(reduce4(ss[0], ss[1], ss[2], ss[3], b0, b1) * (1.f / DM) + EPS);
#pragma unroll
            for (int i = 0; i < 4; ++i) { const int m = mb + i * NGW; if (m < NTOK) {
                const float ri = __builtin_bit_cast(float, __builtin_amdgcn_readlane(__builtin_bit_cast(int, rstd), i));
                u32x2* o8 = (u32x2*)(H + (size_t)m * DM) + lane;
#pragma unroll
                for (int j = 0; j < 4; ++j) { const f32x4 y = v[i][j] * ri * gv[j]; u32x2 w; w.x = pkh(y.x, y.y); w.y = pkh(y.z, y.w); o8[64 * j] = w; } } }
            float lg[4];
#pragma unroll
            for (int c = 0; c < 4; ++c) { const LAS float* w = RW + c * 1024 + 4 * lane;
                lg[c] = reduce4(dot16(v[0], w), dot16(v[1], w), dot16(v[2], w), dot16(v[3], w), b0, b1) * rstd + bgl[c]; }
            int gi = 0; float gm = lg[0];
#pragma unroll
            for (int c = 1; c < 4; ++c) if (lg[c] > gm) { gm = lg[c]; gi = c; }
            float den = 0.f;
#pragma unroll
            for (int c = 0; c < 4; ++c) den += __expf(lg[c] - gm);
            const float gwt = 1.0f / den;
            int gr[4];
#pragma unroll
            for (int i = 0; i < 4; ++i) gr[i] = __builtin_amdgcn_readlane(gi, i);
            float ev[8];
#pragma unroll
            for (int c = 0; c < 8; ++c) {
                const float s0 = dot16(v[0], RW + (4 + 8 * gr[0] + c) * 1024 + 4 * lane), s1 = dot16(v[1], RW + (4 + 8 * gr[1] + c) * 1024 + 4 * lane),
                            s2 = dot16(v[2], RW + (4 + 8 * gr[2] + c) * 1024 + 4 * lane), s3 = dot16(v[3], RW + (4 + 8 * gr[3] + c) * 1024 + 4 * lane);
                ev[c] = reduce4(s0, s1, s2, s3, b0, b1) * rstd + be[8 * gi + c];
                if (c & 1) asm volatile("" ::: "memory"); }
            int i0 = 0; float v0 = ev[0];
#pragma unroll
            for (int c = 1; c < 8; ++c) if (ev[c] > v0) { v0 = ev[c]; i0 = c; }
            int i1 = -1; float v1 = -INFINITY;
#pragma unroll
            for (int c = 0; c < 8; ++c) if (c != i0 && ev[c] > v1) { v1 = ev[c]; i1 = c; }
            const float e1 = __expf(v1 - v0), w0 = gwt / (1.0f + e1), w1 = gwt * e1 / (1.0f + e1);
            const int mrow = mb + (lane & 3) * NGW;
            if ((lane >> 2) == ps && mrow < NTOK) { ke0 = gi * 8 + i0; ke1 = gi * 8 + i1; kw0 = w0; kw1 = w1; km = mrow; }
        }
        STAMP(52);
        unsigned p0 = 0, p1 = 0;
        if (km >= 0) { p0 = __hip_atomic_fetch_add(lcnt + ke0, 1u, __ATOMIC_RELAXED, __HIP_MEMORY_SCOPE_WORKGROUP); p1 = __hip_atomic_fetch_add(lcnt + ke1, 1u, __ATOMIC_RELAXED, __HIP_MEMORY_SCOPE_WORKGROUP); }
        __syncthreads();
        if (F.tid < NEXP) { const unsigned c = lcnt[F.tid]; lbase[F.tid] = c ? atomicAdd(F.cnt + 64 * F.tid, c) : 0u; }
        __syncthreads();
        if (km >= 0) { const int q0 = (int)(lbase[ke0] + p0), q1 = (int)(lbase[ke1] + p1);
            TOK[(size_t)ke0 * LCAP + q0] = km; WL[(size_t)ke0 * LCAP + q0] = kw0; TOK[(size_t)ke1 * LCAP + q1] = km; WL[(size_t)ke1 * LCAP + q1] = kw1;
            ROUTE[km] = (i32x4){ke0, q0, ke1, q1}; }
        __syncthreads();
        STAMP(53);
    }
}
__device__ __forceinline__ void load_counts(Frame& F) {
    __syncthreads();
    if (F.tid < NEXP) F.MISC[64 + F.tid] = __hip_atomic_load(F.cnt + 64 * F.tid, __ATOMIC_RELAXED, __HIP_MEMORY_SCOPE_AGENT);
    __syncthreads();
}
__device__ __forceinline__ void p8_combine(Frame& F) {
    const int gw = F.vcu * 8 + F.wave, NGW = F.G * 8, lane = F.lane;
    const LAS int* cntl = (const LAS int*)(F.MISC + 64); LAS int* pbase = (LAS int*)(F.MISC + 96);
    if (F.tid < NEXP) { int acc = 0; for (int j = 0; j < F.tid; ++j) acc += ((cntl[j] + 255) >> 8) << 8; pbase[F.tid] = acc; }
    __syncthreads();
    const h16* Y = (const h16*)(F.ws + WS_Y); const h16* X1 = (const h16*)(F.ws + WS_X1); const i32x4* ROUTE = (const i32x4*)(F.ws + WS_ROUTE);
    for (int base = 0; base < NTOK; base += NGW * 8) {
        int r0 = 0, r1 = 0;
        { const int m = base + gw + (lane & 7) * NGW; if (m < NTOK) { const i32x4 rt = ROUTE[m]; r0 = pbase[rt.x] + rt.y; r1 = pbase[rt.z] + rt.w; } }
#pragma unroll
        for (int i4 = 0; i4 < 8; i4 += 4) {
            u32x2 xv[4][4], ya[4][4], yb[4][4];
#pragma unroll
            for (int i = 0; i < 4; ++i) { const int m = base + gw + (i4 + i) * NGW; const int mm = m < NTOK ? m : 0;
                const size_t q0 = (size_t)__builtin_amdgcn_readlane(r0, i4 + i), q1 = (size_t)__builtin_amdgcn_readlane(r1, i4 + i);
                const u32x2* xr = (const u32x2*)(X1 + (size_t)mm * DM) + lane; const u32x2* y0 = (const u32x2*)(Y + q0 * DM) + lane; const u32x2* y1 = (const u32x2*)(Y + q1 * DM) + lane;
#pragma unroll
                for (int j = 0; j < 4; ++j) { xv[i][j] = xr[64 * j]; ya[i][j] = y0[64 * j]; yb[i][j] = y1[64 * j]; } }
#pragma unroll
            for (int i = 0; i < 4; ++i) { const int m = base + gw + (i4 + i) * NGW; if (m < NTOK) { f32x4* orow = (f32x4*)(F.out + (size_t)m * DM) + lane;
#pragma unroll
                for (int j = 0; j < 4; ++j) { const h16x4 x = __builtin_bit_cast(h16x4, xv[i][j]), a = __builtin_bit_cast(h16x4, ya[i][j]), b = __builtin_bit_cast(h16x4, yb[i][j]);
                    f32x4 v; v.x = (float)x[0] + ((float)a[0] + (float)b[0]); v.y = (float)x[1] + ((float)a[1] + (float)b[1]); v.z = (float)x[2] + ((float)a[2] + (float)b[2]); v.w = (float)x[3] + ((float)a[3] + (float)b[3]); orow[64 * j] = v; } } }
        }
    }
}

__global__ void __launch_bounds__(512, 2) hsb_fwd(Args args) {
    extern __shared__ __attribute__((aligned(16))) unsigned char lds[];
    Frame F;
    F.lds = (LAS unsigned char*)lds; F.MISC = (volatile LAS unsigned*)(F.lds + MISC_OFF);
    F.tid = threadIdx.x; F.lane = F.tid & 63; F.wave = __builtin_amdgcn_readfirstlane(F.tid >> 6);
    F.G = gridDim.x; { const int bx = blockIdx.x; F.vcu = (F.G % 8 == 0) ? (bx % 8) * (F.G / 8) + bx / 8 : bx; }
#pragma unroll
    for (int i = 0; i < 17; ++i) F.in[i] = args.in[i];
    F.out = args.out; F.ws = args.ws; F.ctl = (unsigned*)(args.ws + WS_CTL); F.cnt = F.ctl + CW_CNT + args.li * 64 * NEXP;
    for (int u = F.tid; u < 256; u += 512) ((LAS unsigned*)(F.lds + MISC_OFF))[u] = 0u;
    __syncthreads();
    XcdBarrier bar = xcd_barrier_post(F.ctl + CW_BAR + args.li * XCD_BAR_WORDS, F.MISC + 8);
    const int lo = args.ph_lo, hi = args.ph_hi;
#ifndef PH_MASK
#define PH_MASK 0x3ff
#endif
#define IN(k) (((PH_MASK >> (k)) & 1) && lo <= (k) && (k) < hi)
#define SEAM(k) do { if (IN(k) && IN((k) + 1)) xcd_barrier(bar); } while (0)
    unsigned char* ws = args.ws;

#if defined(TS_SEL)
    F.ts0 = 0; F.ts1 = 0;
#define TSP (&F.ts0)
#else
#define TSP nullptr
#endif
    STAMP(0);
    if (IN(0)) { p0_prologue(F); convert_experts(F); } SEAM(0); STAMP(1);
    if (IN(1)) {
        StaticOrder S{(const char*)(ws + WS_H), (const char*)(ws + WS_WIN), NTOK / 256, NPROJ / 256, F.G, (int)blockIdx.x, (size_t)256 * DM * 2};
        EpiProj E{ws, F.in[3], F.in[4]};
        pg8::gemm_phase<EpiProj, StaticOrder, false, 1>(F.lds, DM, S, E, TSP);
    } SEAM(1); STAMP(2);
    if (IN(2)) { p2_attn_conv(F); } SEAM(2); STAMP(3);
    if (IN(3)) {
        BranchOrder S{(const char*)(ws + WS_AO), (const char*)(ws + WS_CO), (const char*)(ws + WS_WSB), (const char*)(ws + WS_WCV), F.G, (int)blockIdx.x};
        EpiBranch E{ws};
        pg8::gemm_phase<EpiBranch, BranchOrder, false, 3>(F.lds, AW, S, E, TSP);
    } SEAM(3); STAMP(4);
    if (IN(4)) {
        StaticOrder S{(const char*)(ws + WS_MRG), (const char*)(ws + WS_WOUT), NTOK / 256, DM / 256, F.G, (int)blockIdx.x, (size_t)256 * DM * 2};
        EpiOut E{F.in[0], (h16*)(ws + WS_X1)};
        pg8::gemm_phase<EpiOut, StaticOrder, false, 4>(F.lds, DM, S, E, TSP);
    } SEAM(4); STAMP(5);
    if (IN(5)) { p5_router(F); } SEAM(5); STAMP(6);
    if (IN(6)) {
        load_counts(F);
        MoeOrder<2, true> S{(const LAS int*)(F.MISC + 64), (const char*)(ws + WS_H), (const char*)(ws + WS_W1), (const int*)(ws + WS_TOK), (const float*)(ws + WS_WL), F.G, F.vcu, 0, F.G};
        EpiAct E{(h16*)(ws + WS_ACT)};
        pg8::gemm_phase<EpiAct, MoeOrder<2, true>, true, 6>(F.lds, DM, S, E, TSP);
    } SEAM(6); STAMP(7);
    if (IN(7)) {
        load_counts(F);
        int T = 0; for (int j = 0; j < NEXP; ++j) T += ((int)F.MISC[64 + j] + 255) >> 8;
        T = __builtin_amdgcn_readfirstlane(T);
        int R = 2 * T - F.G; R = R < 0 ? 0 : (R > F.G / 2 ? F.G / 2 : R);
        const int done_mt = (2 * T < F.G ? 2 * T : F.G) / 2;
        if (F.vcu < R) {
            MoeOrder<2, true> S{(const LAS int*)(F.MISC + 64), (const char*)(ws + WS_H), (const char*)(ws + WS_W1), (const int*)(ws + WS_TOK), (const float*)(ws + WS_WL), R, F.vcu, F.G, 2 * T};
            EpiAct E{(h16*)(ws + WS_ACT)};
            pg8::gemm_phase<EpiAct, MoeOrder<2, true>, true, 7>(F.lds, DM, S, E, TSP);
        } else {
            MoeOrder<4, false> S{(const LAS int*)(F.MISC + 64), (const char*)(ws + WS_ACT), (const char*)(ws + WS_W2), (const int*)(ws + WS_TOK), (const float*)(ws + WS_WL), F.G - R, F.vcu - R, 0, 4 * done_mt};
            EpiY E{(h16*)(ws + WS_Y)};
            pg8::gemm_phase<EpiY, MoeOrder<4, false>, false, 7>(F.lds, DEXP, S, E, TSP);
        }
    } SEAM(7); STAMP(8);
    if (IN(8)) {
        load_counts(F);
        int T = 0; for (int j = 0; j < NEXP; ++j) T += ((int)F.MISC[64 + j] + 255) >> 8;
        T = __builtin_amdgcn_readfirstlane(T);
        const int done_mt = (2 * T < F.G ? 2 * T : F.G) / 2;
        MoeOrder<4, false> S{(const LAS int*)(F.MISC + 64), (const char*)(ws + WS_ACT), (const char*)(ws + WS_W2), (const int*)(ws + WS_TOK), (const float*)(ws + WS_WL), F.G, F.vcu, 4 * done_mt, 4 * T};
        EpiY E{(h16*)(ws + WS_Y)};
        pg8::gemm_phase<EpiY, MoeOrder<4, false>, false, 8>(F.lds, DEXP, S, E, TSP);
    } SEAM(8); STAMP(9);
    if (IN(9)) { load_counts(F); p8_combine(F); }
#if defined(TS_SEL)
    xcd_barrier(bar); STAMP(10);
#if defined(TS_CONST)
    if (blockIdx.x == TS_BLK && F.tid == TS_TID) F.out[0] = (float)(TS_CONST);
#else
    if (blockIdx.x == TS_BLK && F.tid == TS_TID) F.out[0] = ((float)(F.ts1 - F.ts0) * 0.01f - (float)(TS_OFF)) * 0.2f;
#endif
#endif
#undef IN
#undef SEAM
}

extern "C" void kernel_launch(void* const* d_in, const int* in_sizes, int n_in, void* d_out, int out_size, void* d_ws, size_t ws_size, hipStream_t stream) {
    static int grid = 0;
    if (grid == 0) {
        if (n_in != 17 || in_sizes[0] != NTOK * DM || out_size != NTOK * DM || ws_size < WS_END) {
            fprintf(stderr, "kernel_launch: unexpected problem: n_in %d in0 %d out %d ws %zu; nothing launched\n", n_in, n_in > 0 ? in_sizes[0] : -1, out_size, ws_size); grid = -1; return; }
        int dev = 0, cus = 0, per_cu = 0;
        if (hipGetDevice(&dev) != hipSuccess || hipDeviceGetAttribute(&cus, hipDeviceAttributeMultiprocessorCount, dev) != hipSuccess) { fprintf(stderr, "kernel_launch: device query failed\n"); grid = -1; return; }
        if (hipFuncSetAttribute((const void*)hsb_fwd, hipFuncAttributeMaxDynamicSharedMemorySize, LDS_BYTES) != hipSuccess) { fprintf(stderr, "kernel_launch: hipFuncSetAttribute failed\n"); grid = -1; return; }
        if (hipOccupancyMaxActiveBlocksPerMultiprocessor(&per_cu, (const void*)hsb_fwd, 512, LDS_BYTES) != hipSuccess || per_cu < 1) {
            fprintf(stderr, "kernel_launch: occupancy query reports %d workgroups per CU\n", per_cu); (void)hipGetLastError(); per_cu = 1; }
        grid = cus;
    }
    if (grid < 0) return;
    (void)hipMemsetAsync((char*)d_ws + WS_CTL, 0, CTL_BYTES, stream);
    Args a{};
    for (int i = 0; i < 17; ++i) a.in[i] = (const float*)d_in[i];
    a.out = (float*)d_out; a.ws = (unsigned char*)d_ws;
#if defined(PROBE_DUP_LO)
    const int plan[2][2] = {{0, PROBE_DUP_HI}, {PROBE_DUP_LO, N_PHASES}}; const int nl = 2;
#elif MK_N_LAUNCHES == 1
    const int plan[1][2] = {{0, N_PHASES}}; const int nl = 1;
#else
    int plan[N_PHASES][2]; for (int p = 0; p < N_PHASES; ++p) { plan[p][0] = p; plan[p][1] = p + 1; } const int nl = N_PHASES;
#endif
    for (int l = 0; l < nl; ++l) { a.ph_lo = plan[l][0]; a.ph_hi = plan[l][1]; a.li = l; hipLaunchKernelGGL(hsb_fwd, dim3(grid), dim3(512), LDS_BYTES, stream, a); }
}
```

```cpp
#include <hip/hip_runtime.h>
#include <cstdio>
#include <cstdint>

#define LAS __attribute__((address_space(3)))
#define GAS __attribute__((address_space(1)))
typedef _Float16 h16;
typedef h16 h16x8 __attribute__((ext_vector_type(8)));
typedef h16 h16x4 __attribute__((ext_vector_type(4)));
typedef h16 h16x2 __attribute__((ext_vector_type(2)));
typedef float f32x2 __attribute__((ext_vector_type(2)));
typedef float f32x4 __attribute__((ext_vector_type(4)));
typedef float f32x16 __attribute__((ext_vector_type(16)));
typedef unsigned u32x2 __attribute__((ext_vector_type(2)));
typedef unsigned u32x4 __attribute__((ext_vector_type(4)));
typedef int i32x4 __attribute__((ext_vector_type(4)));


constexpr int NTOK = 16384, SEQ = 4096, DM = 1024, NH = 8, HD = 64, AW = 512, NPROJ = 5120, NEXP = 32, DEXP = 256;
constexpr float EPS = 1e-6f;
constexpr int LCAP = 16384;
constexpr size_t MiB = 1u << 20;
constexpr size_t WS_CTL = 0, CTL_BYTES = 160 * 1024;
constexpr size_t WS_RW = 512 * 1024;
constexpr size_t WS_WIN = 1 * MiB, WS_WSB = 11 * MiB, WS_WCV = 12 * MiB, WS_WOUT = 13 * MiB, WS_W1 = 15 * MiB, WS_W2 = 47 * MiB;
constexpr size_t WS_H = 63 * MiB;
constexpr size_t WS_Q = 95 * MiB, WS_K = 111 * MiB, WS_VT = 127 * MiB, WS_CB = 143 * MiB, WS_CC = 159 * MiB, WS_CU = 175 * MiB, WS_GA = 191 * MiB, WS_GB = 223 * MiB;
constexpr size_t WS_AO = WS_CU, WS_CO = WS_CB;
constexpr size_t WS_ACO = WS_H;
constexpr size_t WS_MRG = WS_Q;
constexpr size_t WS_ACT = WS_Q;
constexpr size_t WS_Y = WS_VT;
constexpr size_t WS_X1 = 207 * MiB;
constexpr size_t WS_TOK = 240 * MiB, WS_WL = 242 * MiB, WS_ROUTE = 244 * MiB, WS_RL = 246 * MiB;
constexpr size_t WS_END = 256 * MiB;
constexpr int CW_CNT = 64;
constexpr int CW_P2 = 24576;
constexpr int CW_P3 = 16384, CW_P4 = 20480;
constexpr int CW_DONE = 28672;
constexpr int CW_ED = 6336, CW_LD = 6400;
constexpr int CW_BAR = 8192;
constexpr int CW_P2ALL = 6528, CW_P3ALL = 6592;
constexpr unsigned NTILE_CHAIN = (NTOK / 256) * (DM / 256);
constexpr int CW_BBC = 6656, CW_BBS = 6912, CW_BBT = 7168;

constexpr int RING_BYTES = 131072;
constexpr int SCR_BYTES = 147456;
constexpr int MISC_OFF = SCR_BYTES;
constexpr int LDS_BYTES = SCR_BYTES + 1024;

#define LDS_WAIT() asm volatile("s_waitcnt lgkmcnt(0)" ::: "memory")
#define VM_WAIT() asm volatile("s_waitcnt vmcnt(0)" ::: "memory")

__device__ __forceinline__ unsigned pkh(float lo, float hi) { f32x2 v = {lo, hi}; h16x2 b = __builtin_convertvector(v, h16x2); return __builtin_bit_cast(unsigned, b); }
template <int CTRL, int ROWMASK> __device__ __forceinline__ float dpp_mov(float v) { return __builtin_bit_cast(float, __builtin_amdgcn_update_dpp(0, __builtin_bit_cast(int, v), CTRL, ROWMASK, 0xf, false)); }
__device__ __forceinline__ float row_sum16(float v) {
    v += dpp_mov<0xB1, 0xf>(v); v += dpp_mov<0x4E, 0xf>(v); v += dpp_mov<0x141, 0xf>(v); v += dpp_mov<0x140, 0xf>(v); return v;
}
__device__ __forceinline__ float wave_total(float v) {
    v = row_sum16(v);
    v += dpp_mov<0x142, 0xa>(v);
    v += dpp_mov<0x143, 0xc>(v);
    return __builtin_bit_cast(float, __builtin_amdgcn_readlane(__builtin_bit_cast(int, v), 63));
}
__device__ __forceinline__ float sigmoidf_(float x) { return __builtin_amdgcn_rcpf(1.0f + __expf(-x)); }

namespace pg8 {
constexpr int BM = 256, BK = 64, HALF = 128, HTB = HALF * BK * 2, NXCD = 8, WGM = 8;
__device__ __forceinline__ int lds_byte(int r, int c) { const int st = (r >> 4) * 2 + (c >> 5), rr = r & 15, cc = c & 31, ob = rr * 64 + cc * 2; return st * 1024 + (ob ^ (((ob >> 9) & 1) << 5)); }
__device__ __forceinline__ void stage_rc(int b, int& R, int& C) { const int st = b / 1024, sb = b % 1024, swz = sb ^ (((sb >> 9) & 1) << 5); R = (st >> 1) * 16 + swz / 64; C = (st & 1) * 32 + (swz % 64) / 2; }
__device__ __forceinline__ int perm32(int rho) { const int n = rho >> 4, i = rho & 15; return 8 * (i >> 2) + 4 * n + (i & 3); }

struct Unit { const char* a; const char* a2; const char* b; const int* lst; const float* wl; int pm, pn, e, nrows; };

__device__ __forceinline__ void tile_of(int L, int nM, int nN, int& pm, int& pn) {
    const int nwg = nM * nN; int wgid = L; { const int q = nwg / NXCD, r = nwg % NXCD, xcd0 = wgid % NXCD, off = wgid / NXCD;
        const int xcd = (NXCD == 8 && r == 0) ? (xcd0 >> 1) + 4 * (xcd0 & 1) : xcd0;
        wgid = (xcd < r ? xcd * (q + 1) : r * (q + 1) + (xcd - r) * q) + off; }
    const int nig = WGM * nN, gid = wgid / nig, fm = gid * WGM, gsz = (nM - fm) < WGM ? (nM - fm) : WGM;
    pm = fm + ((wgid % nig) % gsz); pn = (wgid % nig) / gsz;
}

template <class Epi, class Sched, bool GATHER>
__device__ __forceinline__ void gemm_phase(LAS unsigned char* lds, const int K, const Sched& S, const Epi& E) {
    const int tid = threadIdx.x, wid = __builtin_amdgcn_readfirstlane(tid >> 6), lane = tid & 63, wr = wid >> 2, wc = wid & 3, fr = lane & 15, fq = lane >> 4;
    const int nt = K / BK;
    unsigned voffA[2], voffB[2]; int RA[2], CA[2];
#pragma unroll
    for (int i = 0; i < 2; ++i) { int R, C; stage_rc(tid * 16 + i * 8192, R, C); const int Rb = Epi::PERM ? ((R & ~31) + perm32(R & 31)) : R;
        RA[i] = R; CA[i] = C; voffA[i] = (unsigned)(R * (Sched::LDA ? Sched::LDA : K) + C) * 2u; voffB[i] = (unsigned)(Rb * K + C) * 2u; }
    const size_t kstep = (size_t)(BK * 2);
    const size_t hstep = (size_t)HALF * K * 2, hstepA = (size_t)HALF * (Sched::LDA ? Sched::LDA : K) * 2;
    constexpr int KS = Sched::KSPLIT;
#define PG8_APTR(u1, u2, t) ((KS && (t) >= KS) ? (u2) + (size_t)((t) - KS) * kstep : (u1) + (size_t)(t) * kstep)
    const unsigned ldsw = (unsigned)wid * 1024u;
    const int aoff = lds_byte(wr * 64 + fr, fq * 8), boff = lds_byte(wc * 32 + fr, fq * 8);
#define PG8_SA(b, h) (((b) * 2 + (h)) * HTB)
#define PG8_SB(b, h) ((4 + (b) * 2 + (h)) * HTB)
#define PG8_GLDS(bufoff, gptr, i) __builtin_amdgcn_global_load_lds((const unsigned*)(gptr), (LAS unsigned*)(lds + (bufoff) + ldsw + (i) * 8192), 16, 0, 0)
#define PG8_STAGE_B(bufoff, gbase, h) do { PG8_GLDS(bufoff, (const char*)(gbase) + (h) * hstep + voffB[0], 0); PG8_GLDS(bufoff, (const char*)(gbase) + (h) * hstep + voffB[1], 1); } while (0)
#define PG8_STAGE_A(bufoff, gbase, h, v0, v1) do { if constexpr (GATHER) { PG8_GLDS(bufoff, (const char*)(gbase) + (v0), 0); PG8_GLDS(bufoff, (const char*)(gbase) + (v1), 1); } \
        else { PG8_GLDS(bufoff, (const char*)(gbase) + (h) * hstepA + voffA[0], 0); PG8_GLDS(bufoff, (const char*)(gbase) + (h) * hstepA + voffA[1], 1); } } while (0)
#define PG8_LDA(dst, b, h) do { _Pragma("unroll") for (int m = 0; m < 4; ++m) _Pragma("unroll") for (int k = 0; k < 2; ++k) dst[m][k] = *(const LAS h16x8*)(lds + PG8_SA(b, h) + aoff + m * 2048 + k * 1024); } while (0)
#define PG8_LDB(dst, b, h) do { _Pragma("unroll") for (int n = 0; n < 2; ++n) _Pragma("unroll") for (int k = 0; k < 2; ++k) dst[n][k] = *(const LAS h16x8*)(lds + PG8_SB(b, h) + boff + n * 2048 + k * 1024); } while (0)
#define PG8_MMA(ai, bj, At, Bt) do { __builtin_amdgcn_s_setprio(1); _Pragma("unroll") for (int m = 0; m < 4; ++m) _Pragma("unroll") for (int n = 0; n < 2; ++n) _Pragma("unroll") for (int k = 0; k < 2; ++k) \
        acc[ai][bj][m][n] = __builtin_amdgcn_mfma_f32_16x16x32_f16(Bt[n][k], At[m][k], acc[ai][bj][m][n], 0, 0, 0); __builtin_amdgcn_s_setprio(0); } while (0)
#define PG8_WAIT_V(n) asm volatile("s_waitcnt vmcnt(" #n ")" ::: "memory")
#define PG8_WAIT_L(n) asm volatile("s_waitcnt lgkmcnt(" #n ")" ::: "memory")
#define PG8_BAR __builtin_amdgcn_s_barrier()
#define PG8_SCHED __builtin_amdgcn_sched_barrier(0)
    Unit cur, nxt; int ui = 0;
    if (!S.next(0, cur)) return;
    f32x4 acc[2][2][4][2];
#pragma unroll
    for (int a = 0; a < 2; ++a)
#pragma unroll
        for (int b = 0; b < 2; ++b)
#pragma unroll
            for (int m = 0; m < 4; ++m)
#pragma unroll
                for (int n = 0; n < 2; ++n) acc[a][b][m][n] = (f32x4){0.f, 0.f, 0.f, 0.f};
    h16x8 At[4][2], B0[2][2], B1[2][2];
    const char* cA = cur.a; const char* cA2 = cur.a2; const char* cB = cur.b;
    S.a_ready(cur);
    unsigned gc00 = 0, gc01 = 0, gc10 = 0, gc11 = 0, gn00 = 0, gn01 = 0, gn10 = 0, gn11 = 0;
#define PG8_GOFF(u, h, i) ((unsigned)(S.tok(u, (h) * HALF + RA[i]) * K + CA[i]) * 2u)
    if constexpr (GATHER) { gc00 = PG8_GOFF(cur, 0, 0); gc01 = PG8_GOFF(cur, 0, 1); gc10 = PG8_GOFF(cur, 1, 0); gc11 = PG8_GOFF(cur, 1, 1); }
    PG8_STAGE_B(PG8_SB(0, 0), cB, 0); PG8_STAGE_B(PG8_SB(0, 1), cB, 1); PG8_STAGE_A(PG8_SA(0, 0), PG8_APTR(cA, cA2, 0), 0, gc00, gc01); PG8_STAGE_A(PG8_SA(0, 1), PG8_APTR(cA, cA2, 0), 1, gc10, gc11);
    if (wr == 1) PG8_BAR;
    PG8_WAIT_V(2); PG8_BAR;
    PG8_STAGE_B(PG8_SB(1, 0), cB + kstep, 0); PG8_STAGE_A(PG8_SA(1, 0), PG8_APTR(cA, cA2, 1), 0, gc00, gc01); PG8_STAGE_B(PG8_SB(1, 1), cB + kstep, 1);
    PG8_WAIT_V(6); PG8_BAR;
    for (;;) {
        const bool has_next = S.next(ui + 1, nxt);
        const char* nA = has_next ? nxt.a : cA; const char* nA2 = has_next ? nxt.a2 : cA2; const char* nB = has_next ? nxt.b : cB;
        if constexpr (GATHER) { if (has_next) { gn00 = PG8_GOFF(nxt, 0, 0); gn01 = PG8_GOFF(nxt, 0, 1); gn10 = PG8_GOFF(nxt, 1, 0); gn11 = PG8_GOFF(nxt, 1, 1); } else { gn00 = gc00; gn01 = gc01; gn10 = gc10; gn11 = gc11; } }
#pragma unroll 1
        for (int t = 0; t < nt; t += 2) {
            const bool last = (t == nt - 2);
            const char* a1 = PG8_APTR(cA, cA2, t + 1);
            const char* a2 = last ? PG8_APTR(nA, nA2, 0) : PG8_APTR(cA, cA2, t + 2); const char* b2 = last ? nB : cB + (size_t)(t + 2) * kstep;
            const char* a3 = last ? PG8_APTR(nA, nA2, 1) : PG8_APTR(cA, cA2, t + 3); const char* b3 = b2 + kstep;
            if (last && has_next) S.a_ready(nxt);
            if constexpr (Epi::MID) { if (t == nt / 2) { int tz = t - nt / 2; asm volatile("" : "+v"(tz)); E.mid(acc, cur, wr, wc, fr + tz, fq); } }
            unsigned s00 = gc00, s01 = gc01, s10 = gc10, s11 = gc11;
            if constexpr (GATHER) { if (last) { s00 = gn00; s01 = gn01; s10 = gn10; s11 = gn11; } }
            PG8_LDB(B0, 0, 0); PG8_LDB(B1, 0, 1); PG8_SCHED; PG8_LDA(At, 0, 0); PG8_STAGE_A(PG8_SA(1, 1), a1, 1, gc10, gc11);
            PG8_WAIT_V(8); PG8_WAIT_L(0); PG8_BAR; PG8_MMA(0, 0, At, B0); PG8_MMA(0, 1, At, B1); PG8_BAR; PG8_SCHED;
            PG8_LDA(At, 0, 1); PG8_STAGE_B(PG8_SB(0, 0), b2, 0); PG8_STAGE_B(PG8_SB(0, 1), b2, 1); PG8_STAGE_A(PG8_SA(0, 0), a2, 0, s00, s01);
            PG8_WAIT_V(8); PG8_WAIT_L(0); PG8_BAR; PG8_MMA(1, 0, At, B0); PG8_MMA(1, 1, At, B1); PG8_BAR; PG8_SCHED;
            PG8_LDB(B0, 1, 0); PG8_LDB(B1, 1, 1); PG8_SCHED; PG8_LDA(At, 1, 0); PG8_STAGE_A(PG8_SA(0, 1), a2, 1, s10, s11);
            PG8_WAIT_V(8); PG8_WAIT_L(0); PG8_BAR; PG8_MMA(0, 0, At, B0); PG8_MMA(0, 1, At, B1); PG8_BAR; PG8_SCHED;
            PG8_LDA(At, 1, 1); PG8_STAGE_B(PG8_SB(1, 0), b3, 0); PG8_STAGE_B(PG8_SB(1, 1), b3, 1); PG8_STAGE_A(PG8_SA(1, 0), a3, 0, s00, s01);
            PG8_WAIT_V(8); PG8_WAIT_L(0); PG8_BAR; PG8_MMA(1, 0, At, B0); PG8_MMA(1, 1, At, B1); PG8_BAR; PG8_SCHED;
        }
        if (wr == 0) PG8_BAR;
        E(acc, cur, wr, wc, fr, fq);
        if (!has_next) break;
#pragma unroll
        for (int a = 0; a < 2; ++a)
#pragma unroll
            for (int b = 0; b < 2; ++b)
#pragma unroll
                for (int m = 0; m < 4; ++m)
#pragma unroll
                    for (int n = 0; n < 2; ++n) acc[a][b][m][n] = (f32x4){0.f, 0.f, 0.f, 0.f};
        cur = nxt; cA = nA; cA2 = nA2; cB = nB; ++ui;
        if constexpr (GATHER) { gc00 = gn00; gc01 = gn01; gc10 = gn10; gc11 = gn11; }
        if (wr == 1) PG8_BAR;
    }
    PG8_WAIT_V(0);
    PG8_BAR;
#undef PG8_SA
#undef PG8_SB
#undef PG8_GLDS
#undef PG8_STAGE_A
#undef PG8_STAGE_B
#undef PG8_LDA
#undef PG8_LDB
#undef PG8_MMA
#undef PG8_WAIT_V
#undef PG8_WAIT_L
#undef PG8_BAR
#undef PG8_SCHED
#undef PG8_GOFF
#undef PG8_APTR
}
}
using pg8::Unit;

#define XB_TMO      128
#define XB_XCNT(j)  (256  + 64 * (j))
#define XB_XSUB(j)  (1280 + 64 * (j))
#define XB_XGEN(j)  (2304 + 64 * (j))
#define XB_TOP      3328
#define XB_TOPGEN   3392
#define XCD_BAR_WORDS 3456
#define XB_SPIN_CAP (1u << 20)
__device__ __forceinline__ unsigned xb_ld(unsigned* p)              { return __hip_atomic_load(p, __ATOMIC_RELAXED, __HIP_MEMORY_SCOPE_AGENT); }
__device__ __forceinline__ unsigned xb_add(unsigned* p, unsigned v) { return __hip_atomic_fetch_add(p, v, __ATOMIC_RELAXED, __HIP_MEMORY_SCOPE_AGENT); }
__device__ __forceinline__ unsigned xb_xcc_id() { return (unsigned)__builtin_amdgcn_s_getreg((3 << 11) | 20) & 0xFu; }
#define XB_SPIN(cond, bar) do { unsigned _sp = 0; while (cond) { __builtin_amdgcn_s_sleep(1); \
    if ((++_sp & 255u) == 0u) { if (xb_ld(&(bar)[XB_TMO])) break; if (_sp > XB_SPIN_CAP) { atomicAdd(&(bar)[XB_TMO], 1u); break; } } } } while (0)
struct XcdBarrier { unsigned* bar; unsigned x; volatile LAS unsigned* st; };
__device__ __forceinline__ XcdBarrier xcd_barrier_post(unsigned* bar, volatile LAS unsigned* st) {
    XcdBarrier b; b.bar = bar; b.x = xb_xcc_id(); b.st = st;
    if (threadIdx.x == 0) (void)xb_add(&bar[XB_XCNT(b.x)], 1u);
    return b;
}
__device__ __forceinline__ void xcd_barrier_complete(unsigned* bar, unsigned x, unsigned& nloc, unsigned& nx) {
    const unsigned G = gridDim.x * gridDim.y * gridDim.z;
    unsigned sum, cnt, mine, sp = 0u;
    for (;;) {
        sum = 0u; cnt = 0u; mine = 0u;
#pragma unroll
        for (unsigned j = 0; j < 16; ++j) { const unsigned c = xb_ld(&bar[XB_XCNT(j)]); sum += c; cnt += (c > 0u) ? 1u : 0u; mine = (j == x) ? c : mine; }
        if (sum == G) break;
        __builtin_amdgcn_s_sleep(1);
        if ((++sp & 255u) == 0u) { if (xb_ld(&bar[XB_TMO])) break; if (sp > XB_SPIN_CAP) { atomicAdd(&bar[XB_TMO], 1u); break; } }
    }
    nloc = mine > 0u ? mine : 1u; nx = cnt > 0u ? cnt : 1u;
}
__device__ __forceinline__ void xcd_barrier(const XcdBarrier& b) {
    asm volatile("s_waitcnt vmcnt(0)" ::: "memory");
    __syncthreads();
    if (threadIdx.x == 0) {
        unsigned* bar = b.bar;
        __builtin_amdgcn_s_waitcnt(0);
        unsigned nloc = b.st[0], nx = b.st[1];
        if (nloc == 0u) { xcd_barrier_complete(bar, b.x, nloc, nx); b.st[0] = nloc; b.st[1] = nx; }
        const unsigned old = xb_add(&bar[XB_XSUB(b.x)], 1u);
        const unsigned gen = old / nloc;
        if (old + 1u == (gen + 1u) * nloc) {
            __builtin_amdgcn_fence(__ATOMIC_RELEASE, "agent");
            asm volatile("s_waitcnt vmcnt(0)" ::: "memory");
            const unsigned og = xb_add(&bar[XB_TOP], 1u);
            const unsigned tg = og / nx;
            if (og + 1u == (tg + 1u) * nx) xb_add(&bar[XB_TOPGEN], 1u);
            else XB_SPIN(xb_ld(&bar[XB_TOPGEN]) == tg, bar);
            __builtin_amdgcn_fence(__ATOMIC_ACQUIRE, "agent");
            xb_add(&bar[XB_XGEN(b.x)], 1u);
            asm volatile("s_waitcnt vmcnt(0)" ::: "memory");
        } else {
            XB_SPIN(xb_ld(&bar[XB_XGEN(b.x)]) == gen, bar);
            __builtin_amdgcn_fence(__ATOMIC_ACQUIRE, "agent");
            asm volatile("s_waitcnt vmcnt(0)" ::: "memory");
        }
    }
    __syncthreads();
}

__device__ __forceinline__ void st16_wt(__amdgpu_buffer_rsrc_t rsrc, unsigned byte_off, u32x4 v) { __builtin_amdgcn_raw_buffer_store_b128(v, rsrc, byte_off, 0,   16); }
__device__ __forceinline__ void panel_publish(unsigned* word) { if (threadIdx.x == 0) __hip_atomic_fetch_add(word, 1u, __ATOMIC_RELAXED, __HIP_MEMORY_SCOPE_AGENT); }
__device__ __forceinline__ void panel_wait(unsigned* word, unsigned need, unsigned* tmo) {
    if (threadIdx.x == 0) { unsigned sp = 0;
        while (__hip_atomic_load(word, __ATOMIC_RELAXED, __HIP_MEMORY_SCOPE_AGENT) < need) { __builtin_amdgcn_s_sleep(1);
            if ((++sp & 255u) == 0u) { if (__hip_atomic_load(tmo, __ATOMIC_RELAXED, __HIP_MEMORY_SCOPE_AGENT)) break; if (sp > XB_SPIN_CAP) { atomicAdd(tmo, 1u); break; } } }
        __builtin_amdgcn_fence(__ATOMIC_ACQUIRE, "agent");
        asm volatile("s_waitcnt vmcnt(0)" ::: "memory"); }
    __syncthreads();
}
__device__ __forceinline__ void all_done_wait(unsigned* word, unsigned need, unsigned* tmo) {
    unsigned sp = 0;
    while ((unsigned)__builtin_amdgcn_readfirstlane(__hip_atomic_load(word, __ATOMIC_RELAXED, __HIP_MEMORY_SCOPE_AGENT)) < need) { __builtin_amdgcn_s_sleep(1);
        if ((++sp & 255u) == 0u) { if (__hip_atomic_load(tmo, __ATOMIC_RELAXED, __HIP_MEMORY_SCOPE_AGENT)) break; if (sp > XB_SPIN_CAP) { atomicAdd(tmo, 1u); break; } } }
    asm volatile("s_waitcnt vmcnt(0)" ::: "memory");
}
__device__ __forceinline__ void batch_barrier(unsigned* ctl, unsigned xcc, int b, unsigned* tmo) {
    asm volatile("s_waitcnt vmcnt(0)" ::: "memory");
    __syncthreads();
    if (threadIdx.x == 0) {
        unsigned tot = 0u, nloc = 0u;
#pragma unroll
        for (unsigned j = 0; j < 16; ++j) { const unsigned c = xb_ld(ctl + CW_BBC + 4 * (j * 4 + b)); tot += c; nloc = (j == xcc) ? c : nloc; }
        const unsigned old = xb_add(ctl + CW_BBS + 4 * (xcc * 4 + b), 1u);
        if (old + 1u == nloc) {
            __builtin_amdgcn_fence(__ATOMIC_RELEASE, "agent");
            asm volatile("s_waitcnt vmcnt(0)" ::: "memory");
            (void)xb_add(ctl + CW_BBT + 16 * b, nloc);
        }
        unsigned sp = 0;
        while (xb_ld(ctl + CW_BBT + 16 * b) < tot) { __builtin_amdgcn_s_sleep(1);
            if ((++sp & 255u) == 0u) { if (xb_ld(tmo)) break; if (sp > XB_SPIN_CAP) { atomicAdd(tmo, 1u); break; } } }
        __builtin_amdgcn_fence(__ATOMIC_ACQUIRE, "agent");
        asm volatile("s_waitcnt vmcnt(0)" ::: "memory");
    }
    __syncthreads();
}
struct Args { const float* in[17]; float* out; unsigned char* ws; int ph_lo, ph_hi; };
struct Frame {
    LAS unsigned char* lds; volatile LAS unsigned* MISC; unsigned* ctl;
    int tid, lane, wave, vcu, G; unsigned* cnt;
    const float* in[17]; float* out; unsigned char* ws;
};

__device__ __forceinline__ void p0_transpose_item(const float* W, int ldw, h16* WT, int K, int k0, int n0, int drow0, LAS float* scr, int lane, int kd = -1) {
    if (kd < 0) kd = k0;
    float tv[32];
#pragma unroll
    for (int i = 0; i < 32; ++i) tv[i] = __builtin_nontemporal_load(W + (size_t)(k0 + 2 * i + (lane >> 5)) * ldw + n0 + (lane & 31));
#pragma unroll
    for (int i = 0; i < 32; ++i) scr[(2 * i + (lane >> 5)) * 33 + (lane & 31)] = tv[i];
    LDS_WAIT(); asm volatile("" ::: "memory");
    const int c = lane & 7;
#pragma unroll
    for (int j = 0; j < 4; ++j) { const int n = (lane >> 3) + 8 * j; const LAS float* s = scr + (8 * c) * 33 + n;
        u32x4 o; o.x = pkh(s[0 * 33], s[1 * 33]); o.y = pkh(s[2 * 33], s[3 * 33]); o.z = pkh(s[4 * 33], s[5 * 33]); o.w = pkh(s[6 * 33], s[7 * 33]);
        *(u32x4*)(WT + (size_t)(drow0 + n) * K + kd + 8 * c) = o; }
    LDS_WAIT(); asm volatile("" ::: "memory");
}
__device__ __forceinline__ void p0_prologue(Frame& F) {
    LAS float* scr = (LAS float*)(F.lds + F.wave * 16384);
    const int gw = F.vcu * 8 + F.wave, NGW = F.G * 8, lane = F.lane;
    unsigned char* ws = F.ws;
    constexpr int I_IN = 16 * 160, I_SB = 8 * 32, I_CV = 8 * 32, I_OUT = 16 * 32, I_G = 32 * 16 * 8, I_U = I_G, I_D = 32 * 4 * 32;
    constexpr int NITEMS = I_IN + I_SB + I_CV + I_OUT;
    for (int it = gw; it < NITEMS; it += NGW) {
        int r = it;
        if (r < I_IN) { const int kb = r / 160, nb = r % 160, n0 = nb * 32; int drow = n0;
            if (n0 < 1536) { const int tile = n0 >> 8, within = n0 & 255, wc = within >> 6, bj = (within >> 5) & 1; drow = tile * 256 + 128 * bj + 32 * wc; }
            else if (n0 >= 2048 && n0 < 3072) { const int cu = n0 >= 2560, ch = n0 - (cu ? 2560 : 2048); drow = (8 + (ch >> 7)) * 256 + 128 * cu + (ch & 127); }
            else if (n0 >= 3072) { const int gb = n0 >= 4096, ch = n0 - (gb ? 4096 : 3072); drow = (12 + (ch >> 7)) * 256 + 128 * gb + (ch & 127); }
            p0_transpose_item(F.in[2], NPROJ, (h16*)(ws + WS_WIN), DM, kb * 64, n0, drow, scr, lane); continue; } r -= I_IN;
        if (r < I_SB) { const int kb = r / 32, nb = r % 32; p0_transpose_item(F.in[6], DM, (h16*)(ws + WS_WSB), DM, kb * 64, nb * 32, nb * 32, scr, lane); continue; } r -= I_SB;
        if (r < I_CV) { const int kb = r / 32, nb = r % 32; p0_transpose_item(F.in[7], DM, (h16*)(ws + WS_WSB), DM, kb * 64, nb * 32, nb * 32, scr, lane, AW + kb * 64); continue; } r -= I_CV;
        { const int kb = r / 32, nb = r % 32; p0_transpose_item(F.in[8], DM, (h16*)(ws + WS_WOUT), DM, kb * 64, nb * 32, nb * 32, scr, lane); }
    }
    { float* RW = (float*)(ws + WS_RW); const float* g2 = F.in[9]; const float* wg = F.in[10]; const float* we = F.in[12];
      for (int i = (F.vcu * 8 + F.wave) * 64 + lane; i < 36 * 1024; i += F.G * 512) { const int c = i >> 10, k = i & 1023; RW[i] = g2[k] * (c < 4 ? wg[k * 4 + c] : we[k * 32 + (c - 4)]); } }
    { const float* g1 = F.in[1]; h16* H = (h16*)(ws + WS_H);
      f32x4 gv[4];
#pragma unroll
      for (int j = 0; j < 4; ++j) gv[j] = ((const f32x4*)g1)[lane + 64 * j];
      for (int m0 = gw; m0 < NTOK; m0 += 4 * NGW) {
        f32x4 v[4][4];
#pragma unroll
        for (int i = 0; i < 4; ++i) { const int m = m0 + i * NGW; const f32x4* xr = (const f32x4*)(F.in[0] + (size_t)(m < NTOK ? m : m0) * DM) + lane;
#pragma unroll
            for (int j = 0; j < 4; ++j) v[i][j] = __builtin_nontemporal_load(xr + 64 * j); }
#pragma unroll
        for (int i = 0; i < 4; ++i) { const int m = m0 + i * NGW; if (m < NTOK) { float s = 0.f;
#pragma unroll
            for (int j = 0; j < 4; ++j) s += (v[i][j].x * v[i][j].x + v[i][j].y * v[i][j].y) + (v[i][j].z * v[i][j].z + v[i][j].w * v[i][j].w);
            const float rstd = rsqrtf(wave_total(s) * (1.f / DM) + EPS);
            u32x2* o8 = (u32x2*)(H + (size_t)m * DM) + lane;
#pragma unroll
            for (int j = 0; j < 4; ++j) { const f32x4 y = v[i][j] * rstd * gv[j]; u32x2 w; w.x = pkh(y.x, y.y); w.y = pkh(y.z, y.w); o8[64 * j] = w; } } }
      } }
}

struct XItem { const float* src; h16* dst; int ldw, K, kg; };
__device__ __forceinline__ XItem expert_item(const Frame& F, int it) {
    constexpr int I_G = 32 * 16 * 8; XItem x; int r = it;
    if (r < 2 * I_G) { const int up = r >= I_G; if (up) r -= I_G; const int e = r / 128, q = r % 128, kb = q / 8, nb = q % 8, n0 = nb * 32;
        const int drow = 256 * (n0 >> 7) + 128 * up + (n0 & 127);
        x.src = F.in[up ? 15 : 14] + (size_t)e * DM * DEXP + (size_t)(kb * 64) * DEXP + n0; x.ldw = DEXP; x.K = DM; x.kg = kb * 64;
        x.dst = (h16*)(F.ws + WS_W1) + ((size_t)e * 512 + drow) * DM + kb * 64; }
    else { r -= 2 * I_G; const int e = r / 128, q = r % 128, kb = q / 32, nb = q % 32;
        x.src = F.in[16] + (size_t)e * DEXP * DM + (size_t)(kb * 64) * DM + nb * 32; x.ldw = DM; x.K = DEXP; x.kg = -1;
        x.dst = (h16*)(F.ws + WS_W2) + ((size_t)e * DM + nb * 32) * DEXP + kb * 64; }
    return x;
}
__device__ __forceinline__ void convert_experts(Frame& F, const int dv, const int k0, const int k1) {
    LAS float* scr0 = (LAS float*)(F.lds + F.wave * 18432);
    const int NGW = F.G * 8, lane = F.lane, ks = lane >> 3, n4 = lane & 7, w0 = (F.vcu + dv) * 8 + F.wave, gw = w0 + k0 * NGW;
    constexpr int NIT_ALL = 2 * 32 * 16 * 8 + 32 * 4 * 32;
    const int NIT = min(NIT_ALL, w0 + k1 * NGW);
    if (k0 >= k1 || gw >= NIT) return;
    XItem cur[2]; bool cv[2]; f32x4 tv[2][8];
#pragma unroll
    for (int p = 0; p < 2; ++p) { const int ii = gw + p * NGW; cv[p] = ii < NIT; cur[p] = expert_item(F, cv[p] ? ii : gw);
        if (cv[p]) {
#pragma unroll
            for (int i = 0; i < 8; ++i) tv[p][i] = __builtin_nontemporal_load((const f32x4*)(cur[p].src + (size_t)(8 * i + ks) * cur[p].ldw + 4 * n4)); } }
    for (int it = gw; it < NIT; it += 2 * NGW) {
        XItem nxt[2]; bool nv[2]; f32x4 tn[2][8];
        const int c = lane & 7;
        f32x4 ga[2], gb[2];
#pragma unroll
        for (int p = 0; p < 2; ++p) { ga[p] = (f32x4){1.f, 1.f, 1.f, 1.f}; gb[p] = ga[p];
            if (cv[p] && cur[p].kg >= 0) { ga[p] = *(const f32x4*)(F.in[9] + cur[p].kg + 8 * c); gb[p] = *(const f32x4*)(F.in[9] + cur[p].kg + 8 * c + 4); } }
        asm volatile("" ::: "memory");
#pragma unroll
        for (int p = 0; p < 2; ++p) { const int ii = it + (2 + p) * NGW; nv[p] = ii < NIT; nxt[p] = cur[p];
            if (nv[p]) { nxt[p] = expert_item(F, ii);
#pragma unroll
                for (int i = 0; i < 8; ++i) tn[p][i] = __builtin_nontemporal_load((const f32x4*)(nxt[p].src + (size_t)(8 * i + ks) * nxt[p].ldw + 4 * n4)); } }
        asm volatile("" ::: "memory");
#pragma unroll
        for (int p = 0; p < 2; ++p) if (cv[p]) { LAS float* scr = scr0 + p * (64 * 33) + ks * 33 + 4 * n4;
#pragma unroll
            for (int i = 0; i < 8; ++i) { scr[(8 * i) * 33 + 0] = tv[p][i].x; scr[(8 * i) * 33 + 1] = tv[p][i].y; scr[(8 * i) * 33 + 2] = tv[p][i].z; scr[(8 * i) * 33 + 3] = tv[p][i].w; } }
        LDS_WAIT(); asm volatile("" ::: "memory");
#pragma unroll
        for (int p = 0; p < 2; ++p) if (cv[p]) { const LAS float* scr = scr0 + p * (64 * 33);
#pragma unroll
            for (int j = 0; j < 4; ++j) { const int n = (lane >> 3) + 8 * j; const LAS float* q = scr + (8 * c) * 33 + n;
                u32x4 o; o.x = pkh(q[0 * 33] * ga[p][0], q[1 * 33] * ga[p][1]); o.y = pkh(q[2 * 33] * ga[p][2], q[3 * 33] * ga[p][3]); o.z = pkh(q[4 * 33] * gb[p][0], q[5 * 33] * gb[p][1]); o.w = pkh(q[6 * 33] * gb[p][2], q[7 * 33] * gb[p][3]);
                *(u32x4*)(cur[p].dst + (size_t)n * cur[p].K + 8 * c) = o; } }
        LDS_WAIT(); asm volatile("" ::: "memory");
#pragma unroll
        for (int p = 0; p < 2; ++p) { if (nv[p]) {
#pragma unroll
                for (int i = 0; i < 8; ++i) tv[p][i] = tn[p][i]; }
            cur[p] = nxt[p]; cv[p] = nv[p]; }
    }
}

template <int LDA_ = 0, int KSPLIT_ = 0> struct StaticOrder {
    static constexpr int LDA = LDA_, KSPLIT = KSPLIT_;
    const char* A; const char* Bt; int nM, nN, G, c; size_t tstep; const char* A2 = nullptr; size_t tstepA = 0;
    __device__ __forceinline__ bool next(int i, Unit& u) const {
        const int L = i * G + c; if (L >= nM * nN) return false;
        int pm, pn; pg8::tile_of(L, nM, nN, pm, pn); u.pm = pm; u.pn = pn; u.e = 0; u.nrows = 256; u.lst = nullptr; u.wl = nullptr;
        u.a = A + (size_t)pm * (LDA_ ? tstepA : tstep); u.a2 = LDA_ ? A2 + (size_t)pm * tstepA : u.a; u.b = Bt + (size_t)pn * tstep; return true;
    }
    __device__ __forceinline__ int tok(const Unit&, int) const { return 0; }
    __device__ __forceinline__ void a_ready(const Unit&) const {}
};
struct GateOrder {
    static constexpr int LDA = 0, KSPLIT = 0;
    const char* A; const char* Bt; int pm, pn; size_t tstep;
    __device__ __forceinline__ bool next(int i, Unit& u) const {
        if (i >= 2) return false;
        u.pm = pm; u.pn = 12 + 2 * pn + i; u.e = 0; u.nrows = 256; u.lst = nullptr; u.wl = nullptr;
        u.a = A + (size_t)pm * tstep; u.a2 = u.a; u.b = Bt + (size_t)u.pn * tstep; return true;
    }
    __device__ __forceinline__ int tok(const Unit&, int) const { return 0; }
    __device__ __forceinline__ void a_ready(const Unit&) const {}
};
template <int NN, bool G1> struct MoeOrder {
    static constexpr int LDA = 0, KSPLIT = 0;
    const LAS int* cntl; const char* A; const char* Bt; const int* tok_list; const float* w_list; int G, c, lo, hi;
    __device__ __forceinline__ bool next(int i, Unit& u) const {
        const int L = lo + i * G + c; if (L >= hi || c < 0) return false;
        const int mtg = L / NN, pn = L % NN;
        const int ln = threadIdx.x & 63;
        const int te = ln < NEXP ? cntl[128 + ln] : 0x7fffffff;
        const unsigned long long bal = __ballot(te <= mtg);
        int e = __builtin_popcountll(bal & 0xffffffffull); if (e >= NEXP) return false;
        e = __builtin_amdgcn_readfirstlane(e);
        const int st = e ? cntl[128 + e - 1] : 0; const int mtl = __builtin_amdgcn_readfirstlane(mtg - st), ce = __builtin_amdgcn_readfirstlane(cntl[e]);
        u.pm = mtg; u.pn = pn; u.e = e; const int nr = ce - mtl * 256; u.nrows = nr < 256 ? nr : 256;
        u.lst = tok_list + (size_t)e * LCAP + mtl * 256; u.wl = w_list + (size_t)e * LCAP + mtl * 256;
        if (G1) { u.a = A; u.b = Bt + ((size_t)e * 512 + pn * 256) * DM * 2; }
        else { u.a = A + (size_t)mtg * 256 * DEXP * 2; u.b = Bt + ((size_t)e * DM + pn * 256) * DEXP * 2; }
        u.a2 = u.a;
        return true;
    }
    __device__ __forceinline__ int tok(const Unit& u, int r) const { return r < u.nrows ? u.lst[r] : 0; }
    __device__ __forceinline__ void a_ready(const Unit&) const {}
};
struct DownOrder {
    static constexpr int LDA = 0, KSPLIT = 0;
    MoeOrder<4, false> early, late; unsigned* done; unsigned* tmo;
    __device__ __forceinline__ bool next(int i, Unit& u) const {
        const int ne = early.hi > early.lo + early.c ? (early.hi - early.lo - early.c + early.G - 1) / early.G : 0;
        return i < ne ? early.next(i, u) : late.next(i - ne, u);
    }
    __device__ __forceinline__ int tok(const Unit&, int) const { return 0; }
    __device__ __forceinline__ void a_ready(const Unit& u) const {
        if (threadIdx.x < 64) {
            unsigned sp = 0;
            while ((unsigned)__builtin_amdgcn_readfirstlane(__hip_atomic_load(done + 16 * u.pm, __ATOMIC_RELAXED, __HIP_MEMORY_SCOPE_AGENT)) < 2u) {
                __builtin_amdgcn_s_sleep(1);
                if ((++sp & 255u) == 0u) { if (__hip_atomic_load(tmo, __ATOMIC_RELAXED, __HIP_MEMORY_SCOPE_AGENT)) break; if (sp > XB_SPIN_CAP) { atomicAdd(tmo, 1u); break; } } }
            __builtin_amdgcn_fence(__ATOMIC_ACQUIRE, "agent");
            asm volatile("s_waitcnt vmcnt(0)" ::: "memory");
        }
        asm volatile("" ::: "memory"); __builtin_amdgcn_s_barrier(); asm volatile("" ::: "memory");
    }
};

__device__ __forceinline__ u32x4 pack8(const f32x4 a, const f32x4 b) { u32x4 w; w.x = pkh(a[0], a[1]); w.y = pkh(a[2], a[3]); w.z = pkh(b[0], b[1]); w.w = pkh(b[2], b[3]); return w; }
__device__ __forceinline__ void unpack8(const u32x4 w, f32x4& a, f32x4& b) {
    const h16x8 h = __builtin_bit_cast(h16x8, w);
    a = (f32x4){(float)h[0], (float)h[1], (float)h[2], (float)h[3]}; b = (f32x4){(float)h[4], (float)h[5], (float)h[6], (float)h[7]};
}
struct EpiProj {
    static constexpr bool PERM = true, MID = false;
    unsigned char* ws; const float* qg; const float* kg;
    __device__ __forceinline__ void operator()(const f32x4 (&acc)[2][2][4][2], const Unit& u, int wr, int wc, int fr, int fq) const {
        const int row0 = u.pm * 256 + wr * 64 + fr, pn = u.pn;
        if (pn < 4) {
            const bool isq = pn < 2; const int head = 4 * (pn & 1) + wc; const float* gp = isq ? qg : kg; const float sc = isq ? 0.125f * 1.4426950408889634f : 1.0f;
            h16* dst = (h16*)(ws + (isq ? WS_Q : WS_K));
            const f32x4 g00 = *(const f32x4*)(gp + 8 * fq), g01 = *(const f32x4*)(gp + 8 * fq + 4), g10 = *(const f32x4*)(gp + 32 + 8 * fq), g11 = *(const f32x4*)(gp + 32 + 8 * fq + 4);
#pragma unroll
            for (int ai = 0; ai < 2; ++ai)
#pragma unroll
                for (int m = 0; m < 4; ++m) {
                    const f32x4 a0 = acc[ai][0][m][0], a1 = acc[ai][0][m][1], b0 = acc[ai][1][m][0], b1 = acc[ai][1][m][1];
                    float ss = (a0[0] * a0[0] + a0[1] * a0[1]) + (a0[2] * a0[2] + a0[3] * a0[3]) + (a1[0] * a1[0] + a1[1] * a1[1]) + (a1[2] * a1[2] + a1[3] * a1[3])
                             + (b0[0] * b0[0] + b0[1] * b0[1]) + (b0[2] * b0[2] + b0[3] * b0[3]) + (b1[0] * b1[0] + b1[1] * b1[1]) + (b1[2] * b1[2] + b1[3] * b1[3]);
                    ss += __shfl_xor(ss, 16); ss += __shfl_xor(ss, 32);
                    const float r = rsqrtf(ss * (1.f / HD) + EPS) * sc;
                    h16* rowp = dst + (size_t)(row0 + ai * 128 + m * 16) * AW + head * HD + 8 * fq;
                    *(u32x4*)(rowp) = pack8(a0 * r * g00, a1 * r * g01);
                    *(u32x4*)(rowp + 32) = pack8(b0 * r * g10, b1 * r * g11);
                }
        } else if (pn < 6) {
            const int head = 4 * (pn & 1) + wc; h16* VT = (h16*)(ws + WS_VT);
            const int pf = fr ^ ((((fr >> 2) ^ (fr >> 3)) & 1) ? 12 : 0);
#pragma unroll
            for (int ai = 0; ai < 2; ++ai)
#pragma unroll
                for (int m = 0; m < 4; ++m) {
                    const int row = row0 + ai * 128 + m * 16, b = row >> 12, s = row & (SEQ - 1);
                    h16* colp = VT + ((size_t)(b * NH + head) * HD + 8 * fq) * SEQ + (s & ~15) + pf;
#pragma unroll
                    for (int bj = 0; bj < 2; ++bj)
#pragma unroll
                        for (int n = 0; n < 2; ++n)
#pragma unroll
                            for (int j = 0; j < 4; ++j) colp[(size_t)(32 * bj + 4 * n + j) * SEQ] = (h16)acc[ai][bj][m][n][j];
                }
        } else if (pn >= 8 && pn < 12) {
            h16* dst = (h16*)(ws + WS_CC); const int col0 = (pn - 8) * 128 + wc * 32 + 8 * fq;
#pragma unroll
            for (int ai = 0; ai < 2; ++ai)
#pragma unroll
                for (int m = 0; m < 4; ++m) *(u32x4*)(dst + (size_t)(row0 + ai * 128 + m * 16) * AW + col0) = pack8(acc[ai][0][m][0] * acc[ai][1][m][0], acc[ai][0][m][1] * acc[ai][1][m][1]);
        } else if (pn >= 12) {
            h16* ra = (h16*)(ws + WS_GA); h16* sb = (h16*)(ws + WS_GB); const int col0 = (pn - 12) * 128 + wc * 32 + 8 * fq;
#pragma unroll
            for (int ai = 0; ai < 2; ++ai)
#pragma unroll
                for (int m = 0; m < 4; ++m) { f32x4 r0, r1, b0, b1;
#pragma unroll
                    for (int j = 0; j < 4; ++j) { b0[j] = fmaxf(sigmoidf_(acc[ai][1][m][0][j]), 6.103515625e-5f); b1[j] = fmaxf(sigmoidf_(acc[ai][1][m][1][j]), 6.103515625e-5f);
                        r0[j] = sigmoidf_(acc[ai][0][m][0][j]) * __builtin_amdgcn_rcpf(b0[j]); r1[j] = sigmoidf_(acc[ai][0][m][1][j]) * __builtin_amdgcn_rcpf(b1[j]); }
                    const size_t off = (size_t)(row0 + ai * 128 + m * 16) * DM + col0;
                    *(u32x4*)(ra + off) = pack8(r0, r1); *(u32x4*)(sb + off) = pack8(b0, b1); }
        } else {
            h16* dst = (h16*)(ws + WS_CB); const int col0 = (pn - 6) * 256 + wc * 32 + 8 * fq;
#pragma unroll
            for (int ai = 0; ai < 2; ++ai)
#pragma unroll
                for (int m = 0; m < 4; ++m) { h16* rowp = dst + (size_t)(row0 + ai * 128 + m * 16) * AW + col0;
#pragma unroll
                    for (int bj = 0; bj < 2; ++bj) *(u32x4*)(rowp + bj * 128) = pack8(acc[ai][bj][m][0], acc[ai][bj][m][1]); }
        }
    }
};
struct EpiMerge {
    static constexpr bool PERM = true, MID = true;
    unsigned char* ws; unsigned* ctl;
    __device__ __forceinline__ void mid(f32x4 (&acc)[2][2][4][2], const Unit& u, int wr, int wc, int fr, int fq) const {
        const int row0 = u.pm * 256 + wr * 64 + fr; const int col0 = u.pn * 256 + wc * 32 + 8 * fq;
        const h16* ra = (const h16*)(ws + WS_GA);
#pragma unroll
        for (int ai = 0; ai < 2; ++ai) {
            u32x4 qa[4][2];
#pragma unroll
            for (int m = 0; m < 4; ++m)
#pragma unroll
                for (int bj = 0; bj < 2; ++bj) qa[m][bj] = *(const u32x4*)(ra + (size_t)(row0 + ai * 128 + m * 16) * DM + col0 + bj * 128);
#pragma unroll
            for (int m = 0; m < 4; ++m)
#pragma unroll
                for (int bj = 0; bj < 2; ++bj) { f32x4 a0, a1; unpack8(qa[m][bj], a0, a1); acc[ai][bj][m][0] *= a0; acc[ai][bj][m][1] *= a1; }
            asm volatile("" ::: "memory"); }
    }
    __device__ __forceinline__ void operator()(const f32x4 (&acc)[2][2][4][2], const Unit& u, int wr, int wc, int fr, int fq) const {
        const int row0 = u.pm * 256 + wr * 64 + fr; const int col0 = u.pn * 256 + wc * 32 + 8 * fq;
        const h16* gb = (const h16*)(ws + WS_GB);
        all_done_wait(ctl + CW_P2ALL, NTILE_CHAIN, ctl + CW_BAR + XB_TMO);
        const __amdgpu_buffer_rsrc_t mr = __builtin_amdgcn_make_buffer_rsrc((void*)(ws + WS_MRG), 0, 32 * 1024 * 1024, 0x00020000);
#pragma unroll
        for (int ai = 0; ai < 2; ++ai) {
            u32x4 qb[4][2];
#pragma unroll
            for (int m = 0; m < 4; ++m)
#pragma unroll
                for (int bj = 0; bj < 2; ++bj) qb[m][bj] = *(const u32x4*)(gb + (size_t)(row0 + ai * 128 + m * 16) * DM + col0 + bj * 128);
#pragma unroll
            for (int m = 0; m < 4; ++m)
#pragma unroll
                for (int bj = 0; bj < 2; ++bj) { f32x4 b0, b1; unpack8(qb[m][bj], b0, b1);
                    st16_wt(mr, (unsigned)(((size_t)(row0 + ai * 128 + m * 16) * DM + col0 + bj * 128) * 2), pack8(acc[ai][bj][m][0] * b0, acc[ai][bj][m][1] * b1)); } }
    }
};
struct EpiOut {
    static constexpr bool PERM = true, MID = false;
    const float* x; h16* x1; unsigned* ctl;
    __device__ __forceinline__ void operator()(const f32x4 (&acc)[2][2][4][2], const Unit& u, int wr, int wc, int fr, int fq) const {
        const int row0 = u.pm * 256 + wr * 64 + fr, col0 = u.pn * 256 + wc * 32 + 8 * fq;
        all_done_wait(ctl + CW_P3ALL, NTILE_CHAIN, ctl + CW_BAR + XB_TMO);
        const __amdgpu_buffer_rsrc_t xr = __builtin_amdgcn_make_buffer_rsrc((void*)x1, 0, 32 * 1024 * 1024, 0x00020000);
#pragma unroll
        for (int ai = 0; ai < 2; ++ai) {
            f32x4 xv[4][2][2];
#pragma unroll
            for (int m = 0; m < 4; ++m)
#pragma unroll
                for (int bj = 0; bj < 2; ++bj)
#pragma unroll
                    for (int n = 0; n < 2; ++n) xv[m][bj][n] = __builtin_nontemporal_load((const f32x4*)(x + (size_t)(row0 + ai * 128 + m * 16) * DM + col0 + bj * 128 + n * 4));
#pragma unroll
            for (int m = 0; m < 4; ++m)
#pragma unroll
                for (int bj = 0; bj < 2; ++bj) st16_wt(xr, (unsigned)(((size_t)(row0 + ai * 128 + m * 16) * DM + col0 + bj * 128) * 2), pack8(xv[m][bj][0] + acc[ai][bj][m][0], xv[m][bj][1] + acc[ai][bj][m][1])); }
    }
};
struct EpiAct {
    static constexpr bool PERM = true, MID = false;
    h16* act;
    __device__ __forceinline__ void operator()(const f32x4 (&acc)[2][2][4][2], const Unit& u, int wr, int wc, int fr, int fq) const {
        const int r0 = wr * 64 + fr; const int col0 = u.pn * 128 + wc * 32 + 8 * fq;
        const __amdgpu_buffer_rsrc_t arsrc = __builtin_amdgcn_make_buffer_rsrc((void*)act, 0, 40960 * DEXP * 2, 0x00020000);
        float wv[2][4], rv[2][4];
#pragma unroll
        for (int ai = 0; ai < 2; ++ai)
#pragma unroll
            for (int m = 0; m < 4; ++m) { const int r = r0 + ai * 128 + m * 16; wv[ai][m] = r < u.nrows ? u.wl[r] : 0.f; rv[ai][m] = r < u.nrows ? u.wl[r + (WS_RL - WS_WL) / 4] : 0.f; }
#pragma unroll
        for (int ai = 0; ai < 2; ++ai)
#pragma unroll
            for (int m = 0; m < 4; ++m) { const int r = r0 + ai * 128 + m * 16; const float rs = rv[ai][m], w = wv[ai][m] * rs;
                f32x4 v0, v1;
#pragma unroll
                for (int j = 0; j < 4; ++j) { const float g0 = acc[ai][0][m][0][j] * rs, g1 = acc[ai][0][m][1][j] * rs;
                    v0[j] = g0 * sigmoidf_(g0) * acc[ai][1][m][0][j] * w; v1[j] = g1 * sigmoidf_(g1) * acc[ai][1][m][1][j] * w; }
                st16_wt(arsrc, (unsigned)(((size_t)(u.pm * 256 + r) * DEXP + col0) * 2), pack8(v0, v1)); }
    }
};
struct EpiY {
    static constexpr bool PERM = true, MID = false;
    h16* y;
    __device__ __forceinline__ void operator()(const f32x4 (&acc)[2][2][4][2], const Unit& u, int wr, int wc, int fr, int fq) const {
        const int row0 = u.pm * 256 + wr * 64 + fr, col0 = u.pn * 256 + wc * 32 + 8 * fq;
        const __amdgpu_buffer_rsrc_t yr = __builtin_amdgcn_make_buffer_rsrc((void*)y, 0, 40960 * DM * 2, 0x00020000);
#pragma unroll
        for (int ai = 0; ai < 2; ++ai)
#pragma unroll
            for (int m = 0; m < 4; ++m) {
                if (wr * 64 + fr + ai * 128 + m * 16 < u.nrows) {
#pragma unroll
                for (int bj = 0; bj < 2; ++bj) st16_wt(yr, (unsigned)(((size_t)(row0 + ai * 128 + m * 16) * DM + col0 + bj * 128) * 2), pack8(acc[ai][bj][m][0], acc[ai][bj][m][1])); } }
    }
};

constexpr float SB_EXIT = 25.0f;
__device__ __forceinline__ void attn_stage(LAS unsigned char* st, const h16* kbase, const h16* vbase, int kt) {
#pragma unroll
    for (int s = 0; s < 4; ++s) __builtin_amdgcn_global_load_lds((const unsigned*)(kbase + (size_t)(kt * 32) * AW + 16 * s), (LAS unsigned*)(st + s * 1024), 16, 0, 0);
#pragma unroll
    for (int db = 0; db < 2; ++db)
#pragma unroll
        for (int s2 = 0; s2 < 2; ++s2) __builtin_amdgcn_global_load_lds((const unsigned*)(vbase + (size_t)(32 * db) * SEQ + kt * 32 + 16 * s2), (LAS unsigned*)(st + (4 + 2 * db + s2) * 1024), 16, 0, 0);
}
__device__ __forceinline__ void sb_block(const f32x16& p, float& run, const bool diag, const int r, const int hh, h16x8& bp0, h16x8& bp1) {
    float sp[16];
#pragma unroll
    for (int i = 0; i < 16; ++i) { const float z = p[i]; float v = fmaxf(z, 0.f) + __builtin_amdgcn_logf(1.0f + __builtin_amdgcn_exp2f(-fabsf(z)));
        if (diag) { const int key = (i & 3) + 8 * (i >> 2) + 4 * hh; v = key < r ? v : 0.f; }
        sp[i] = v; }
    float G[4], Go[4], T[4];
#pragma unroll
    for (int g = 0; g < 4; ++g) { G[g] = (sp[4 * g] + sp[4 * g + 1]) + (sp[4 * g + 2] + sp[4 * g + 3]); Go[g] = __shfl_xor(G[g], 32); T[g] = G[g] + Go[g]; }
    float base[4];
    base[3] = run; base[2] = run + T[3]; base[1] = base[2] + T[2]; base[0] = base[1] + T[1];
    float a[16];
#pragma unroll
    for (int g = 0; g < 4; ++g) { float t = base[g] + (hh == 0 ? Go[g] : 0.f);
#pragma unroll
        for (int w = 3; w >= 0; --w) { const int i = 4 * g + w; float e = __builtin_amdgcn_exp2f(p[i] - sp[i] - t);
            if (diag) { const int key = (i & 3) + 8 * (i >> 2) + 4 * hh; e = key < r ? e : 0.f; }
            a[i] = e; t += sp[i]; } }
    run = base[0] + T[0];
#pragma unroll
    for (int j = 0; j < 8; ++j) { bp0[j] = (h16)a[j]; bp1[j] = (h16)a[8 + j]; }
}
struct AttnPre { h16x8 bqA[4], bqB[4]; const h16* kbase; const h16* vbase; };
__device__ __forceinline__ void attn_begin(AttnPre& P, int b, int h, int m, const h16* Q, const h16* Kb, const h16* VT, LAS unsigned char* stage, int lane) {
    const int r = lane & 31, hh = lane >> 5;
    const size_t tb = (size_t)b * SEQ;
    P.kbase = Kb + (tb + r) * AW + h * HD + 8 * hh;
    P.vbase = VT + ((size_t)(b * NH + h) * HD + r) * SEQ + 8 * hh;
    attn_stage(stage, P.kbase, P.vbase, 2 * m + 1);
    const h16* qrow = Q + (tb + m * 64 + r) * AW + h * HD + 8 * hh;
#pragma unroll
    for (int s = 0; s < 4; ++s) { P.bqA[s] = *(const h16x8*)(qrow + 16 * s); P.bqB[s] = *(const h16x8*)(qrow + (size_t)32 * AW + 16 * s); }
}
__device__ __forceinline__ void attn_task(Frame& F, const AttnPre& P, int b, int h, int m, h16* AO, LAS unsigned char* stage, int lane) {

    const int r = lane & 31, hh = lane >> 5;
    const size_t tb = (size_t)b * SEQ;
    const h16* kbase = P.kbase; const h16* vbase = P.vbase;
    const int ktop = 2 * m + 1;
    h16x8 bqA[4], bqB[4];
#pragma unroll
    for (int s = 0; s < 4; ++s) { bqA[s] = P.bqA[s]; bqB[s] = P.bqB[s]; }
    f32x16 oA0 = {}, oA1 = {}, oB0 = {}, oB1 = {}; float runA = 0.f, runB = 0.f;
    int buf = 0;
    for (int kt = ktop; kt >= 0; --kt) {
        const LAS unsigned char* st = stage + buf * 8192 + lane * 16;
        h16x8 ak[4], av[2][2];
        VM_WAIT();
#pragma unroll
        for (int s = 0; s < 4; ++s) ak[s] = *(const LAS h16x8*)(st + s * 1024);
#pragma unroll
        for (int db = 0; db < 2; ++db)
#pragma unroll
            for (int s2 = 0; s2 < 2; ++s2) av[db][s2] = *(const LAS h16x8*)(st + (4 + 2 * db + s2) * 1024);
        buf ^= 1;
        attn_stage(stage + buf * 8192, kbase, vbase, kt > 0 ? kt - 1 : 0);
        const bool actA = kt < ktop;
        f32x16 pB = {}, pA = {};
#pragma unroll
        for (int s = 0; s < 4; ++s) pB = __builtin_amdgcn_mfma_f32_32x32x16_f16(ak[s], bqB[s], pB, 0, 0, 0);
        if (actA) {
#pragma unroll
            for (int s = 0; s < 4; ++s) pA = __builtin_amdgcn_mfma_f32_32x32x16_f16(ak[s], bqA[s], pA, 0, 0, 0); }
        h16x8 bp0, bp1;
        sb_block(pB, runB, kt == ktop, r, hh, bp0, bp1);
        oB0 = __builtin_amdgcn_mfma_f32_32x32x16_f16(av[0][0], bp0, oB0, 0, 0, 0);
        oB0 = __builtin_amdgcn_mfma_f32_32x32x16_f16(av[0][1], bp1, oB0, 0, 0, 0);
        oB1 = __builtin_amdgcn_mfma_f32_32x32x16_f16(av[1][0], bp0, oB1, 0, 0, 0);
        oB1 = __builtin_amdgcn_mfma_f32_32x32x16_f16(av[1][1], bp1, oB1, 0, 0, 0);
        if (actA) {
            sb_block(pA, runA, kt == ktop - 1, r, hh, bp0, bp1);
            oA0 = __builtin_amdgcn_mfma_f32_32x32x16_f16(av[0][0], bp0, oA0, 0, 0, 0);
            oA0 = __builtin_amdgcn_mfma_f32_32x32x16_f16(av[0][1], bp1, oA0, 0, 0, 0);
            oA1 = __builtin_amdgcn_mfma_f32_32x32x16_f16(av[1][0], bp0, oA1, 0, 0, 0);
            oA1 = __builtin_amdgcn_mfma_f32_32x32x16_f16(av[1][1], bp1, oA1, 0, 0, 0);
            if (__all(runA > SB_EXIT && runB > SB_EXIT)) break; }
    }

    VM_WAIT();

    const __amdgpu_buffer_rsrc_t ar = __builtin_amdgcn_make_buffer_rsrc((void*)AO, 0, 16 * 1024 * 1024, 0x00020000);
    const unsigned obase = (unsigned)(((tb + m * 64 + r) * AW + h * HD + 8 * hh) * 2);
#define ATT_OUT(o, rowoff, dboff) do { _Pragma("unroll") for (int k = 0; k < 2; ++k) { \
        const unsigned x0 = pkh(o[8 * k], o[8 * k + 1]), x1 = pkh(o[8 * k + 2], o[8 * k + 3]), y0 = pkh(o[8 * k + 4], o[8 * k + 5]), y1 = pkh(o[8 * k + 6], o[8 * k + 7]); \
        const auto s0 = __builtin_amdgcn_permlane32_swap(x0, y0, false, false); const auto s1 = __builtin_amdgcn_permlane32_swap(x1, y1, false, false); \
        st16_wt(ar, obase + (unsigned)(((rowoff) * AW + (dboff) + 16 * k) * 2), (u32x4){s0[0], s1[0], s0[1], s1[1]}); } } while (0)
    ATT_OUT(oA0, 0, 0); ATT_OUT(oA1, 0, 32); ATT_OUT(oB0, 32, 0); ATT_OUT(oB1, 32, 32);
#undef ATT_OUT
}
__device__ __forceinline__ void p2_attn_conv(Frame& F) {
    const int gw = F.vcu * 8 + F.wave, NGW = F.G * 8, lane = F.lane;
    const h16* Q = (const h16*)(F.ws + WS_Q); h16* AO = (h16*)(F.ws + WS_AO); const h16* Kb = (const h16*)(F.ws + WS_K); const h16* VT = (const h16*)(F.ws + WS_VT);

    const h16* CB = (const h16*)(F.ws + WS_CB); h16* CO = (h16*)(F.ws + WS_CO); const h16* CC = (const h16*)(F.ws + WS_CC); const h16* CU = (const h16*)(F.ws + WS_CU); const float* cw = F.in[5];
    const __amdgpu_buffer_rsrc_t cr = __builtin_amdgcn_make_buffer_rsrc((void*)CO, 0, 16 * 1024 * 1024, 0x00020000);
    for (int L = (int)blockIdx.x; L < (NTOK / 256) * (DM / 256); L += F.G) { int pm, pn; pg8::tile_of(L, NTOK / 256, DM / 256, pm, pn);
        const int bh = (pm >> 4) * 8 + F.wave, m = 4 * (pm & 15) + pn;
        AttnPre P; attn_begin(P, bh >> 3, bh & 7, m, Q, Kb, VT, F.lds + F.wave * 16384, lane);
        { const int c = pm * 32 + pn * 8 + F.wave; const int t0 = c * 8; const bool first = (t0 & (SEQ - 1)) == 0;
            const f32x4 w0a = *(const f32x4*)(cw + 8 * lane), w0b = *(const f32x4*)(cw + 8 * lane + 4), w1a = *(const f32x4*)(cw + AW + 8 * lane), w1b = *(const f32x4*)(cw + AW + 8 * lane + 4),
                        w2a = *(const f32x4*)(cw + 2 * AW + 8 * lane), w2b = *(const f32x4*)(cw + 2 * AW + 8 * lane + 4);
            u32x4 rc[10], rb[8];
#pragma unroll
            for (int i = 0; i < 10; ++i) { const int tt = t0 - 2 + i; const size_t off = (size_t)((i < 2 && first) ? t0 : tt) * AW + 8 * lane; rc[i] = *(const u32x4*)(CC + off); }
#pragma unroll
            for (int i = 0; i < 8; ++i) rb[i] = *(const u32x4*)(CB + (size_t)(t0 + i) * AW + 8 * lane);
            f32x4 pa2, pb2, pa1, pb1;
            unpack8(rc[0], pa2, pb2); unpack8(rc[1], pa1, pb1);
            if (first) { pa2 = (f32x4){0.f, 0.f, 0.f, 0.f}; pb2 = pa2; pa1 = pa2; pb1 = pa2; }
#pragma unroll
            for (int i = 0; i < 8; ++i) { f32x4 pa0, pb0, b0, b1;
                unpack8(rc[i + 2], pa0, pb0); unpack8(rb[i], b0, b1);
                const f32x4 ya = b0 * (w0a * pa2 + w1a * pa1 + w2a * pa0), yb = b1 * (w0b * pb2 + w1b * pb1 + w2b * pb0);
                st16_wt(cr, (unsigned)(((size_t)(t0 + i) * AW + 8 * lane) * 2), pack8(ya, yb));
                pa2 = pa1; pb2 = pb1; pa1 = pa0; pb1 = pb0; } }

        attn_task(F, P, bh >> 3, bh & 7, m, AO, F.lds + F.wave * 16384, lane);
        asm volatile("s_waitcnt vmcnt(0)" ::: "memory");
        if (lane == 0) __hip_atomic_fetch_add(F.ctl + CW_P2 + 64 * pm, 2u, __ATOMIC_RELAXED, __HIP_MEMORY_SCOPE_AGENT); }


}

__device__ __forceinline__ float reduce4(float s0, float s1, float s2, float s3, const bool b0, const bool b1) {
    const float t0 = (b0 ? s1 : s0) + dpp_mov<0xB1, 0xf>(b0 ? s0 : s1);
    const float t1 = (b0 ? s3 : s2) + dpp_mov<0xB1, 0xf>(b0 ? s2 : s3);
    float u = (b1 ? t1 : t0) + dpp_mov<0x4E, 0xf>(b1 ? t0 : t1);
    u += dpp_mov<0x124, 0xf>(u); u += dpp_mov<0x128, 0xf>(u);
    u += __builtin_bit_cast(float, __builtin_amdgcn_ds_swizzle(__builtin_bit_cast(int, u), 0x401F));
    u += __shfl_xor(u, 32);
    return u;
}
__device__ __forceinline__ float dot16(const f32x4 (&v)[4], const LAS float* w) {
    float a = 0.f;
#pragma unroll
    for (int j = 0; j < 4; ++j) { const f32x4 x = *(const LAS f32x4*)(w + 256 * j); a += (v[j].x * x.x + v[j].y * x.y) + (v[j].z * x.z + v[j].w * x.w); }
    return a;
}
__device__ __forceinline__ void p5_router(Frame& F, unsigned* tmo) {
    const int lane = F.lane;

    LAS float* RW = (LAS float*)F.lds;
    { const unsigned char* src = F.ws + WS_RW + lane * 16;
#pragma unroll
      for (int i = 0; i < 18; ++i) __builtin_amdgcn_global_load_lds((const unsigned*)(src + (F.wave * 18 + i) * 1024), (LAS unsigned*)(F.lds + (F.wave * 18 + i) * 1024), 16, 0, 0); }
    LAS unsigned* lcnt = (LAS unsigned*)(F.MISC + 128); LAS unsigned* lbase = (LAS unsigned*)(F.MISC + 160);
    const float* g2 = F.in[9]; const float* bg = F.in[11]; const float* be = F.in[13];
    int* TOK = (int*)(F.ws + WS_TOK); float* WL = (float*)(F.ws + WS_WL); float* RL = (float*)(F.ws + WS_RL); i32x4* ROUTE = (i32x4*)(F.ws + WS_ROUTE);
    const bool b0 = lane & 1, b1 = (lane >> 1) & 1;
    VM_WAIT();
    f32x4 gv[4];
#pragma unroll
    for (int j = 0; j < 4; ++j) gv[j] = ((const f32x4*)g2)[lane + 64 * j];
    const float bgl[4] = {bg[0], bg[1], bg[2], bg[3]};
    for (int L = (int)blockIdx.x; L < (NTOK / 256) * (DM / 256); L += F.G) {
        int pm, pn; pg8::tile_of(L, NTOK / 256, DM / 256, pm, pn);
        const int rowbase = pm * 256 + pn * 64;
        if (F.tid < NEXP) lcnt[F.tid] = 0u;
        panel_wait(F.ctl + CW_P4 + 64 * pm, (unsigned)(DM / 256), tmo);

        int ke0 = 0, ke1 = 0, km = -1; float kw0 = 0.f, kw1 = 0.f, krs = 0.f;
#pragma unroll 1
        for (int ps = 0; ps < 2; ++ps) {
            const int mb = rowbase + F.wave * 8 + 4 * ps;
            f32x4 v[4][4];
#pragma unroll
            for (int i = 0; i < 4; ++i) { const int m = mb + i; const u32x2* xr = (const u32x2*)((const h16*)(F.ws + WS_X1) + (size_t)m * DM) + lane;
#pragma unroll
                for (int j = 0; j < 4; ++j) { const h16x4 t = __builtin_bit_cast(h16x4, xr[64 * j]); v[i][j] = (f32x4){(float)t[0], (float)t[1], (float)t[2], (float)t[3]}; } }
            float ss[4];
#pragma unroll
            for (int i = 0; i < 4; ++i) { float s = 0.f;
#pragma unroll
                for (int j = 0; j < 4; ++j) s += (v[i][j].x * v[i][j].x + v[i][j].y * v[i][j].y) + (v[i][j].z * v[i][j].z + v[i][j].w * v[i][j].w);
                ss[i] = s; }
            const float rstd = rsqrtf(reduce4(ss[0], ss[1], ss[2], ss[3], b0, b1) * (1.f / DM) + EPS);
            float lg[4];
#pragma unroll
            for (int c = 0; c < 4; ++c) { const LAS float* w = RW + c * 1024 + 4 * lane;
                lg[c] = reduce4(dot16(v[0], w), dot16(v[1], w), dot16(v[2], w), dot16(v[3], w), b0, b1) * rstd + bgl[c]; }
            int gi = 0; float gm = lg[0];
#pragma unroll
            for (int c = 1; c < 4; ++c) if (lg[c] > gm) { gm = lg[c]; gi = c; }
            float den = 0.f;
#pragma unroll
            for (int c = 0; c < 4; ++c) den += __expf(lg[c] - gm);
            const float gwt = 1.0f / den;
            int gr[4];
#pragma unroll
            for (int i = 0; i < 4; ++i) gr[i] = __builtin_amdgcn_readlane(gi, i);
            float ev[8];
#pragma unroll
            for (int c = 0; c < 8; ++c) {
                const float s0 = dot16(v[0], RW + (4 + 8 * gr[0] + c) * 1024 + 4 * lane), s1 = dot16(v[1], RW + (4 + 8 * gr[1] + c) * 1024 + 4 * lane),
                            s2 = dot16(v[2], RW + (4 + 8 * gr[2] + c) * 1024 + 4 * lane), s3 = dot16(v[3], RW + (4 + 8 * gr[3] + c) * 1024 + 4 * lane);
                ev[c] = reduce4(s0, s1, s2, s3, b0, b1) * rstd + be[8 * gi + c];
                if (c & 1) asm volatile("" ::: "memory"); }
            int i0 = 0; float v0 = ev[0];
#pragma unroll
            for (int c = 1; c < 8; ++c) if (ev[c] > v0) { v0 = ev[c]; i0 = c; }
            int i1 = -1; float v1 = -INFINITY;
#pragma unroll
            for (int c = 0; c < 8; ++c) if (c != i0 && ev[c] > v1) { v1 = ev[c]; i1 = c; }
            const float e1 = __expf(v1 - v0), w0 = gwt / (1.0f + e1), w1 = gwt * e1 / (1.0f + e1);
            const int mrow = mb + (lane & 3);
            if ((lane >> 2) == ps && mrow < NTOK) { ke0 = gi * 8 + i0; ke1 = gi * 8 + i1; kw0 = w0; kw1 = w1; km = mrow; krs = rstd; }
        }

        unsigned p0 = 0, p1 = 0;
        if (km >= 0) { p0 = __hip_atomic_fetch_add(lcnt + ke0, 1u, __ATOMIC_RELAXED, __HIP_MEMORY_SCOPE_WORKGROUP); p1 = __hip_atomic_fetch_add(lcnt + ke1, 1u, __ATOMIC_RELAXED, __HIP_MEMORY_SCOPE_WORKGROUP); }
        __syncthreads();
        if (F.tid < NEXP) { const unsigned c = lcnt[F.tid]; lbase[F.tid] = c ? atomicAdd(F.cnt + 64 * F.tid, c) : 0u; }
        __syncthreads();
        if (km >= 0) { const int q0 = (int)(lbase[ke0] + p0), q1 = (int)(lbase[ke1] + p1);
            TOK[(size_t)ke0 * LCAP + q0] = km; WL[(size_t)ke0 * LCAP + q0] = kw0; RL[(size_t)ke0 * LCAP + q0] = krs; TOK[(size_t)ke1 * LCAP + q1] = km; WL[(size_t)ke1 * LCAP + q1] = kw1; RL[(size_t)ke1 * LCAP + q1] = krs;
            ROUTE[km] = (i32x4){ke0, q0, ke1, q1}; }
        __syncthreads();

    }
}
__device__ __forceinline__ void load_counts(Frame& F) {
    __syncthreads();
    if (F.tid < NEXP) F.MISC[64 + F.tid] = __hip_atomic_load(F.cnt + 64 * F.tid, __ATOMIC_RELAXED, __HIP_MEMORY_SCOPE_AGENT);
    __syncthreads();
    if (F.tid < NEXP) { unsigned acc = 0; for (int j = 0; j <= F.tid; ++j) acc += (F.MISC[64 + j] + 255u) >> 8; F.MISC[192 + F.tid] = acc; }
    __syncthreads();
}
__device__ __forceinline__ void combine_row(const h16* X1, const h16* Y, float* out, int m, size_t q0, size_t q1, int lane) {
    const u32x2* xr = (const u32x2*)(X1 + (size_t)m * DM) + lane; const u32x2* y0 = (const u32x2*)(Y + q0 * DM) + lane; const u32x2* y1 = (const u32x2*)(Y + q1 * DM) + lane;
    u32x2 xv[4], ya[4], yb[4];
#pragma unroll
    for (int j = 0; j < 4; ++j) { xv[j] = xr[64 * j]; ya[j] = y0[64 * j]; yb[j] = y1[64 * j]; }
    f32x4* orow = (f32x4*)(out + (size_t)m * DM) + lane;
#pragma unroll
    for (int j = 0; j < 4; ++j) { const h16x4 x = __builtin_bit_cast(h16x4, xv[j]), a = __builtin_bit_cast(h16x4, ya[j]), b = __builtin_bit_cast(h16x4, yb[j]);
        f32x4 v; v.x = (float)x[0] + ((float)a[0] + (float)b[0]); v.y = (float)x[1] + ((float)a[1] + (float)b[1]); v.z = (float)x[2] + ((float)a[2] + (float)b[2]); v.w = (float)x[3] + ((float)a[3] + (float)b[3]);
        __builtin_nontemporal_store(v, orow + 64 * j); }
}
__device__ __forceinline__ void p8_combine(Frame& F, unsigned* ed, unsigned need_e, unsigned* ld, unsigned need_l, int done_mt, unsigned* tmo) {
    const int gw = F.vcu * 8 + F.wave, NGW = F.G * 8, lane = F.lane;
    const LAS int* cntl = (const LAS int*)(F.MISC + 64); LAS int* pbase = (LAS int*)(F.MISC + 96);
    if (F.tid < NEXP) { int acc = 0; for (int j = 0; j < F.tid; ++j) acc += ((cntl[j] + 255) >> 8) << 8; pbase[F.tid] = acc; }
    panel_wait(ed, need_e, tmo);
    const h16* Y = (const h16*)(F.ws + WS_Y); const h16* X1 = (const h16*)(F.ws + WS_X1); const i32x4* ROUTE = (const i32x4*)(F.ws + WS_ROUTE);
    for (int base = 0; base < NTOK; base += NGW * 8) {
        int r0 = 0, r1 = 0, nl = 0;
        { const int m = base + gw + (lane & 7) * NGW; if (m < NTOK) { const i32x4 rt = ROUTE[m]; r0 = pbase[rt.x] + rt.y; r1 = pbase[rt.z] + rt.w; nl = ((r0 >> 8) >= done_mt || (r1 >> 8) >= done_mt) ? 1 : 0; } }
        const unsigned latemask = (unsigned)(__ballot(nl != 0) & 0xffull);
#pragma unroll 1
        for (int i = 0; i < 8; ++i) { const int m = base + gw + i * NGW;
            if (m < NTOK && !((latemask >> i) & 1u)) combine_row(X1, Y, F.out, m, (size_t)__builtin_amdgcn_readlane(r0, i), (size_t)__builtin_amdgcn_readlane(r1, i), lane); }
        panel_wait(ld, need_l, tmo);
#pragma unroll 1
        for (int i = 0; i < 8; ++i) { const int m = base + gw + i * NGW;
            if (m < NTOK && ((latemask >> i) & 1u)) combine_row(X1, Y, F.out, m, (size_t)__builtin_amdgcn_readlane(r0, i), (size_t)__builtin_amdgcn_readlane(r1, i), lane); }
    }
}

__global__ void __launch_bounds__(512, 2) hsb_fwd(Args args) {
    extern __shared__ __attribute__((aligned(16))) unsigned char lds[];
    Frame F;
    F.lds = (LAS unsigned char*)lds; F.MISC = (volatile LAS unsigned*)(F.lds + MISC_OFF);
    F.tid = threadIdx.x; F.lane = F.tid & 63; F.wave = __builtin_amdgcn_readfirstlane(F.tid >> 6);
    F.G = gridDim.x; { const int bx = blockIdx.x; F.vcu = (F.G % 8 == 0) ? (bx % 8) * (F.G / 8) + bx / 8 : bx; }
#pragma unroll
    for (int i = 0; i < 17; ++i) F.in[i] = args.in[i];
    F.out = args.out; F.ws = args.ws; F.ctl = (unsigned*)(args.ws + WS_CTL); F.cnt = F.ctl + CW_CNT;
    for (int u = F.tid; u < 256; u += 512) ((LAS unsigned*)(F.lds + MISC_OFF))[u] = 0u;
    __syncthreads();
    XcdBarrier bar = xcd_barrier_post(F.ctl + CW_BAR, F.MISC + 8);
    int my_batch; { int pm0, pn0; pg8::tile_of((int)blockIdx.x, NTOK / 256, DM / 256, pm0, pn0); my_batch = pm0 >> 4; }
    const bool batch_sync = (F.G == 256);
    if (batch_sync && F.tid == 0) (void)xb_add(F.ctl + CW_BBC + 4 * ((int)bar.x * 4 + my_batch), 1u);
    const int lo = args.ph_lo, hi = args.ph_hi;
#define IN(k) (lo <= (k) && (k) < hi)
#define SEAM(k) do { if (IN(k) && IN((k) + 1)) xcd_barrier(bar); } while (0)
    unsigned char* ws = args.ws;


    const bool conv_head = (blockIdx.x & 1) == 0;
    constexpr int CONV_TAIL_K = 5;
    const bool conv_shift = (F.G % 16) == 0;
    if (IN(0)) { p0_prologue(F); } SEAM(0);
    if (IN(1)) {
        if (conv_head) { convert_experts(F, 0, 0, 4096); if (conv_shift) convert_experts(F, F.G / 8, CONV_TAIL_K, 4096); __syncthreads(); }
        StaticOrder<> S{(const char*)(ws + WS_H), (const char*)(ws + WS_WIN), NTOK / 256, 12, F.G, (int)blockIdx.x, (size_t)256 * DM * 2};
        EpiProj E{ws, F.in[3], F.in[4]};
        pg8::gemm_phase<EpiProj, StaticOrder<>, false>(F.lds, DM, S, E);
    }
    if (batch_sync) { if (IN(1) && IN(2)) batch_barrier(F.ctl, bar.x, my_batch, bar.bar + XB_TMO); } else SEAM(1);
    if (IN(2)) {
        p2_attn_conv(F); __syncthreads();
        for (int L = (int)blockIdx.x; L < (NTOK / 256) * (DM / 256); L += F.G) { int pm, pn; pg8::tile_of(L, NTOK / 256, DM / 256, pm, pn);
            GateOrder S{(const char*)(ws + WS_H), (const char*)(ws + WS_WIN), pm, pn, (size_t)256 * DM * 2};
            EpiProj E{ws, F.in[3], F.in[4]};
            pg8::gemm_phase<EpiProj, GateOrder, false>(F.lds, DM, S, E); } }
    if (IN(3)) {
        for (int L = (int)blockIdx.x; L < (NTOK / 256) * (DM / 256); L += F.G) { int pm, pn; pg8::tile_of(L, NTOK / 256, DM / 256, pm, pn); panel_wait(F.ctl + CW_P2 + 64 * pm, 64u, bar.bar + XB_TMO);
            if (F.tid == 0) __hip_atomic_fetch_add(F.ctl + CW_P2ALL, 1u, __ATOMIC_RELAXED, __HIP_MEMORY_SCOPE_AGENT); }
        typedef StaticOrder<AW, AW / 64> SO3;
        SO3 S{(const char*)(ws + WS_AO), (const char*)(ws + WS_WSB), NTOK / 256, DM / 256, F.G, (int)blockIdx.x, (size_t)256 * DM * 2, (const char*)(ws + WS_CO), (size_t)256 * AW * 2};
        EpiMerge E{ws, F.ctl};
        pg8::gemm_phase<EpiMerge, SO3, false>(F.lds, DM, S, E);
        for (int L = (int)blockIdx.x; L < (NTOK / 256) * (DM / 256); L += F.G) { int pm, pn; pg8::tile_of(L, NTOK / 256, DM / 256, pm, pn); panel_publish(F.ctl + CW_P3 + 64 * pm); }
    }
    if (IN(4)) {
        for (int L = (int)blockIdx.x; L < (NTOK / 256) * (DM / 256); L += F.G) { int pm, pn; pg8::tile_of(L, NTOK / 256, DM / 256, pm, pn); panel_wait(F.ctl + CW_P3 + 64 * pm, (unsigned)(DM / 256), bar.bar + XB_TMO);
            if (F.tid == 0) __hip_atomic_fetch_add(F.ctl + CW_P3ALL, 1u, __ATOMIC_RELAXED, __HIP_MEMORY_SCOPE_AGENT); }
        StaticOrder<> S{(const char*)(ws + WS_MRG), (const char*)(ws + WS_WOUT), NTOK / 256, DM / 256, F.G, (int)blockIdx.x, (size_t)256 * DM * 2};
        EpiOut E{F.in[0], (h16*)(ws + WS_X1), F.ctl};
        pg8::gemm_phase<EpiOut, StaticOrder<>, false>(F.lds, DM, S, E);
        for (int L = (int)blockIdx.x; L < (NTOK / 256) * (DM / 256); L += F.G) { int pm, pn; pg8::tile_of(L, NTOK / 256, DM / 256, pm, pn); panel_publish(F.ctl + CW_P4 + 64 * pm); }
    }
    if (IN(5)) { p5_router(F, bar.bar + XB_TMO); if (!conv_head) convert_experts(F, 0, 0, conv_shift ? CONV_TAIL_K : 4096); } SEAM(5);
    if (IN(6)) {
        load_counts(F);
        int T = 0; for (int j = 0; j < NEXP; ++j) T += ((int)F.MISC[64 + j] + 255) >> 8;
        T = __builtin_amdgcn_readfirstlane(T);
        int R = 2 * T - F.G; R = R < 0 ? 0 : (R > F.G / 2 ? F.G / 2 : R);
        const int done_mt = (2 * T < F.G ? 2 * T : F.G) / 2;
        unsigned* done = F.ctl + CW_DONE;
        const LAS int* cl = (const LAS int*)(F.MISC + 64);
        { MoeOrder<2, true> S{cl, (const char*)(ws + WS_X1), (const char*)(ws + WS_W1), (const int*)(ws + WS_TOK), (const float*)(ws + WS_WL), F.G, F.vcu, 0, F.G};
          EpiAct E{(h16*)(ws + WS_ACT)};
          pg8::gemm_phase<EpiAct, MoeOrder<2, true>, true>(F.lds, DM, S, E);
          if (F.tid == 0 && F.vcu < 2 * T) __hip_atomic_fetch_add(done + 16 * (F.vcu >> 1), 1u, __ATOMIC_RELAXED, __HIP_MEMORY_SCOPE_AGENT); }
        if (F.vcu < R) {
            for (int L = F.G + F.vcu; L < 2 * T; L += R) {
                MoeOrder<2, true> S{cl, (const char*)(ws + WS_X1), (const char*)(ws + WS_W1), (const int*)(ws + WS_TOK), (const float*)(ws + WS_WL), 1, 0, L, L + 1};
                EpiAct E{(h16*)(ws + WS_ACT)};
                pg8::gemm_phase<EpiAct, MoeOrder<2, true>, true>(F.lds, DM, S, E);
                if (F.tid == 0) __hip_atomic_fetch_add(done + 16 * (L >> 1), 1u, __ATOMIC_RELAXED, __HIP_MEMORY_SCOPE_AGENT);
            }
        } else {
            { MoeOrder<4, false> S{cl, (const char*)(ws + WS_ACT), (const char*)(ws + WS_W2), (const int*)(ws + WS_TOK), (const float*)(ws + WS_WL), F.G - R, F.vcu - R, 0, 4 * done_mt};
              if (F.tid < 64) { const int L = F.lane * (F.G - R) + (F.vcu - R); const bool mine = L < 4 * done_mt; unsigned sp = 0;
                  while (__any(mine && __hip_atomic_load(done + 16 * (L >> 2), __ATOMIC_RELAXED, __HIP_MEMORY_SCOPE_AGENT) < 2u)) { __builtin_amdgcn_s_sleep(1);
                      if ((++sp & 255u) == 0u) { if (__hip_atomic_load(bar.bar + XB_TMO, __ATOMIC_RELAXED, __HIP_MEMORY_SCOPE_AGENT)) break; if (sp > XB_SPIN_CAP) { atomicAdd(bar.bar + XB_TMO, 1u); break; } } }
                  __builtin_amdgcn_fence(__ATOMIC_ACQUIRE, "agent");
                  asm volatile("s_waitcnt vmcnt(0)" ::: "memory"); }
              __syncthreads();
              EpiY E{(h16*)(ws + WS_Y)};
              pg8::gemm_phase<EpiY, MoeOrder<4, false>, false>(F.lds, DEXP, S, E); }
            if (F.tid == 0) __hip_atomic_fetch_add(F.ctl + CW_ED, 1u, __ATOMIC_RELAXED, __HIP_MEMORY_SCOPE_AGENT);
            const int n_late = 4 * (T - done_mt), GD = F.G - R, d = GD - 1 - (F.vcu - R);
            if (d < n_late) {
                MoeOrder<4, false> S{cl, (const char*)(ws + WS_ACT), (const char*)(ws + WS_W2), (const int*)(ws + WS_TOK), (const float*)(ws + WS_WL), GD, d, 4 * done_mt, 4 * T};
                DownOrder SD{S, S, done, bar.bar + XB_TMO}; SD.late.lo = 0; SD.late.hi = 0;
                EpiY E{(h16*)(ws + WS_Y)};
                pg8::gemm_phase<EpiY, DownOrder, false>(F.lds, DEXP, SD, E);
                if (F.tid == 0) __hip_atomic_fetch_add(F.ctl + CW_LD, (unsigned)((n_late - d + GD - 1) / GD), __ATOMIC_RELAXED, __HIP_MEMORY_SCOPE_AGENT);
            }
        }
        p8_combine(F, F.ctl + CW_ED, (unsigned)(F.G - R), F.ctl + CW_LD, (unsigned)(4 * (T - done_mt)), done_mt, bar.bar + XB_TMO);
    }
#undef IN
#undef SEAM
}

extern "C" void kernel_launch(void* const* d_in, const int* in_sizes, int n_in, void* d_out, int out_size, void* d_ws, size_t ws_size, hipStream_t stream) {
    static int grid = 0;
    if (grid == 0) {
        if (n_in != 17 || in_sizes[0] != NTOK * DM || out_size != NTOK * DM || ws_size < WS_END) {
            fprintf(stderr, "kernel_launch: unexpected problem: n_in %d in0 %d out %d ws %zu; nothing launched\n", n_in, n_in > 0 ? in_sizes[0] : -1, out_size, ws_size); grid = -1; return; }
        int dev = 0, cus = 0, per_cu = 0;
        if (hipGetDevice(&dev) != hipSuccess || hipDeviceGetAttribute(&cus, hipDeviceAttributeMultiprocessorCount, dev) != hipSuccess) { fprintf(stderr, "kernel_launch: device query failed\n"); grid = -1; return; }
        if (hipFuncSetAttribute((const void*)hsb_fwd, hipFuncAttributeMaxDynamicSharedMemorySize, LDS_BYTES) != hipSuccess) { fprintf(stderr, "kernel_launch: hipFuncSetAttribute failed\n"); grid = -1; return; }
        if (hipOccupancyMaxActiveBlocksPerMultiprocessor(&per_cu, (const void*)hsb_fwd, 512, LDS_BYTES) != hipSuccess || per_cu < 1) {
            fprintf(stderr, "kernel_launch: occupancy query reports %d workgroups per CU\n", per_cu); (void)hipGetLastError(); per_cu = 1; }
        grid = cus;
    }
    if (grid < 0) return;
    (void)hipMemsetAsync((char*)d_ws + WS_CTL, 0, CTL_BYTES, stream);
    Args a{};
    for (int i = 0; i < 17; ++i) a.in[i] = (const float*)d_in[i];
    a.out = (float*)d_out; a.ws = (unsigned char*)d_ws;
    a.ph_lo = 0; a.ph_hi = 10;
    hipLaunchKernelGGL(hsb_fwd, dim3(grid), dim3(512), LDS_BYTES, stream, a);
}
```
